# Optimizing an MI355X kernel written in HIP

```python
import jax, jax.numpy as jnp
from jax import lax
import numpy as np

D_MODEL = 1024
BATCH = 32
SEQ = 2048
DEPTH = 4

N_EVEN = (DEPTH + 1) // 2
N_ODD = DEPTH // 2

ATT_HEADS = 8
ATT_KV_HEADS = 2
ATT_HEAD_DIM = 64
WINDOW = 128
ROPE_THETA = 10000.0
ATT_WIDTH = ATT_HEADS * ATT_HEAD_DIM
KV_WIDTH = ATT_KV_HEADS * ATT_HEAD_DIM
POOL_WINDOWS = (2, 4, 8, 16)
POOL_GROUP = 128
POOL_WIDTH = POOL_GROUP * len(POOL_WINDOWS)
AB_IN = ATT_WIDTH + 2 * KV_WIDTH + POOL_WIDTH
AB_OUT = ATT_WIDTH + POOL_WIDTH
HGRN_EXPAND = 128
HGRN_HEADS = D_MODEL // HGRN_EXPAND
HGRN_DK = HGRN_EXPAND
HGRN_DV = D_MODEL // HGRN_HEADS
HGRN_KWIDTH = HGRN_HEADS * HGRN_DK
HGRN_VWIDTH = HGRN_HEADS * HGRN_DV
HGRN_IN = 2 * HGRN_KWIDTH + 2 * HGRN_VWIDTH
HGRN_CHUNK = 32
D_FF = 2816
NORM_EPS = 1e-6
GATE_EPS = 1e-6

kernel_name = "hybrid_swa_pool_hgrn2_macaron"


def rms_norm(x, gain):
    xf = x.astype(jnp.float32)
    y = xf * lax.rsqrt(jnp.mean(xf * xf, axis=-1, keepdims=True) + NORM_EPS)
    return (y * gain.astype(jnp.float32)).astype(x.dtype)


def swiglu(x, w_gate, w_up, w_down):
    return (jax.nn.silu(x @ w_gate) * (x @ w_up)) @ w_down


def rope(x, positions):
    half = x.shape[-1] // 2
    inv_freq = ROPE_THETA ** (-jnp.arange(half, dtype=jnp.float32) / half)
    ang = positions.astype(jnp.float32)[:, None] * inv_freq[None, :]
    cos = jnp.cos(ang)[None, :, None, :]
    sin = jnp.sin(ang)[None, :, None, :]
    xf = x.astype(jnp.float32)
    x1, x2 = xf[..., :half], xf[..., half:]
    return jnp.concatenate([x1 * cos - x2 * sin, x2 * cos + x1 * sin], axis=-1).astype(x.dtype)


def sliding_window_attention(q, k, v, sinks):
    B, T, H, d = q.shape
    nb = T // WINDOW
    G = H // ATT_KV_HEADS
    qb = q.reshape(B, nb, WINDOW, ATT_KV_HEADS, G, d).transpose(1, 0, 2, 3, 4, 5)

    def band_keys(a):
        ab = a.reshape(B, nb, WINDOW, ATT_KV_HEADS, d)
        prev = jnp.pad(ab, ((0, 0), (1, 0), (0, 0), (0, 0), (0, 0)))[:, :nb]
        return jnp.concatenate([prev, ab], axis=2).transpose(1, 0, 2, 3, 4)

    k_win, v_win = band_keys(k), band_keys(v)
    r = jnp.arange(WINDOW)[:, None]
    c = jnp.arange(2 * WINDOW)[None, :]
    rel = WINDOW + r - c
    band = (rel >= 0) & (rel < WINDOW)
    sink = sinks.astype(jnp.float32).reshape(ATT_KV_HEADS, G)[None, :, :, None, None]
    scale = d ** -0.5

    def block(args):
        qi, ki, vi, idx = args
        s = jnp.einsum('bqkgd,bskd->bkgqs', qi.astype(jnp.float32), ki.astype(jnp.float32)) * scale
        mask = band & ((c >= WINDOW) | (idx > 0))
        s = jnp.where(mask, s, -jnp.inf)
        m = jnp.maximum(jnp.max(s, axis=-1, keepdims=True), sink)
        p = jnp.where(mask, jnp.exp(s - m), 0.0)
        denom = jnp.sum(p, axis=-1, keepdims=True) + jnp.exp(sink - m)
        o = jnp.einsum('bkgqs,bskd->bqkgd', p / denom, vi.astype(jnp.float32))
        return o.astype(qi.dtype)

    out = lax.map(block, (qb, k_win, v_win, jnp.arange(nb)))
    return out.transpose(1, 0, 2, 3, 4, 5).reshape(B, T, H * d)


def multiscale_pool(u, w_pool, pool_scale):
    T = u.shape[1]
    uf = u.astype(jnp.float32)
    cs = jnp.cumsum(uf, axis=1)
    count = jnp.arange(1, T + 1, dtype=jnp.float32)[None, :, None]
    outs = []
    for gi, w in enumerate(POOL_WINDOWS):
        sl = slice(gi * POOL_GROUP, (gi + 1) * POOL_GROUP)
        cg = cs[..., sl]
        lag = jnp.pad(cg, ((0, 0), (w, 0), (0, 0)))[:, :T]
        mean = (cg - lag) / jnp.minimum(count, float(w))
        outs.append((mean - uf[..., sl]).astype(u.dtype) @ w_pool[gi])
    return jnp.concatenate(outs, axis=-1) * pool_scale


def hgrn2_chunkwise(q, f_logit, v, lb):
    B, T, H, dk = q.shape
    dv = v.shape[-1]
    C = HGRN_CHUNK
    nc = T // C
    lbf = lb.astype(jnp.float32).reshape(H, dk)
    z = f_logit.astype(jnp.float32)
    sig = jax.nn.sigmoid(z)
    f = lbf + (1.0 - lbf) * sig
    log_f = jnp.log(jnp.maximum(f, GATE_EPS))
    key = 1.0 - f
    qf = jax.nn.silu(q.astype(jnp.float32))

    def to_chunks(a):
        return a.reshape(B, nc, C, H, a.shape[-1]).swapaxes(0, 1)

    causal = jnp.tril(jnp.ones((C, C), dtype=bool))[None, :, :, None, None]

    def step(S, inp):
        qc, kc, gc, vc = inp
        Gc = jnp.cumsum(gc, axis=1)
        o_inter = jnp.einsum('bchk,bhkv->bchv', qc * jnp.exp(Gc), S)
        diff = jnp.where(causal, Gc[:, :, None] - Gc[:, None, :], 0.0)
        decay = jnp.where(causal, jnp.exp(diff), 0.0)
        scores = jnp.einsum('bthk,btshk,bshk->bhts', qc, decay, kc)
        o_intra = jnp.einsum('bhts,bshv->bthv', scores, vc)
        G_last = Gc[:, -1]
        S = jnp.exp(G_last)[..., None] * S + jnp.einsum(
            'bshk,bshv->bhkv', kc * jnp.exp(G_last[:, None] - Gc), vc)
        return S, o_inter + o_intra

    S0 = jnp.zeros((B, H, dk, dv), jnp.float32)
    _, o = lax.scan(step, S0, (to_chunks(qf), to_chunks(key), to_chunks(log_f),
                               to_chunks(v.astype(jnp.float32))))
    return o.swapaxes(0, 1).reshape(B, T, H, dv)


def attn_pool_mixer(h, positions, w_in, w_out, q_gain, k_gain, sinks, w_pool, pool_scale):
    B, T, _ = h.shape
    proj = h @ w_in
    q, k, v, u = jnp.split(proj, [ATT_WIDTH, ATT_WIDTH + KV_WIDTH, ATT_WIDTH + 2 * KV_WIDTH], axis=-1)
    q = rope(rms_norm(q.reshape(B, T, ATT_HEADS, ATT_HEAD_DIM), q_gain), positions)
    k = rope(rms_norm(k.reshape(B, T, ATT_KV_HEADS, ATT_HEAD_DIM), k_gain), positions)
    v = v.reshape(B, T, ATT_KV_HEADS, ATT_HEAD_DIM)
    a = sliding_window_attention(q, k, v, sinks)
    p = multiscale_pool(u, w_pool, pool_scale)
    return jnp.concatenate([a, p], axis=-1) @ w_out


def hgrn_mixer(h, w_in, w_out, out_gain, lb):
    B, T, _ = h.shape
    proj = h @ w_in
    q, f, i, g = jnp.split(proj, [HGRN_KWIDTH, 2 * HGRN_KWIDTH, 2 * HGRN_KWIDTH + HGRN_VWIDTH], axis=-1)
    o = hgrn2_chunkwise(q.reshape(B, T, HGRN_HEADS, HGRN_DK), f.reshape(B, T, HGRN_HEADS, HGRN_DK),
                        i.reshape(B, T, HGRN_HEADS, HGRN_DV), lb)
    gate = jax.nn.sigmoid(g.reshape(B, T, HGRN_HEADS, HGRN_DV).astype(jnp.float32))
    o = rms_norm(o * gate, out_gain).astype(h.dtype).reshape(B, T, HGRN_VWIDTH)
    return o @ w_out


def setup_inputs(seed: int = 0) -> dict:
    key = jax.random.key(seed)
    ks = jax.random.split(key, 16)
    f32 = jnp.float32

    def w(k, shape, fan_in):
        return jax.random.normal(k, shape, f32) * fan_in ** -0.5

    x = jax.random.normal(ks[0], (BATCH, SEQ, D_MODEL), f32)
    positions = jnp.arange(SEQ, dtype=jnp.int32)
    norm_gains = 1.0 + 0.1 * jax.random.normal(ks[1], (DEPTH, 3, D_MODEL), f32)
    ffn_w_gate = w(ks[2], (DEPTH, 2, D_MODEL, D_FF), D_MODEL)
    ffn_w_up = w(ks[3], (DEPTH, 2, D_MODEL, D_FF), D_MODEL)
    ffn_w_down = w(ks[4], (DEPTH, 2, D_FF, D_MODEL), D_FF)
    ab_w_in = w(ks[5], (N_EVEN, D_MODEL, AB_IN), D_MODEL)
    ab_w_out = w(ks[6], (N_EVEN, AB_OUT, D_MODEL), AB_OUT)
    q_norm_gain = 1.0 + 0.1 * jax.random.normal(ks[7], (N_EVEN, ATT_HEAD_DIM), f32)
    k_norm_gain = 1.0 + 0.1 * jax.random.normal(ks[8], (N_EVEN, ATT_HEAD_DIM), f32)
    attn_sinks = 0.5 * jax.random.normal(ks[9], (N_EVEN, ATT_HEADS), f32)
    pool_w = w(ks[10], (N_EVEN, len(POOL_WINDOWS), POOL_GROUP, POOL_GROUP), POOL_GROUP)
    pool_scale = 1.0 + 0.1 * jax.random.normal(ks[11], (N_EVEN, POOL_WIDTH), f32)
    c_w_in = w(ks[12], (N_ODD, D_MODEL, HGRN_IN), D_MODEL)
    c_w_out = w(ks[13], (N_ODD, HGRN_VWIDTH, D_MODEL), HGRN_VWIDTH)
    c_out_norm_gain = 1.0 + 0.1 * jax.random.normal(ks[14], (N_ODD, HGRN_DV), f32)
    lb_logits = jax.random.normal(ks[15], (N_ODD, HGRN_KWIDTH), f32)
    return {"x": x, "positions": positions, "norm_gains": norm_gains,
            "ffn_w_gate": ffn_w_gate, "ffn_w_up": ffn_w_up, "ffn_w_down": ffn_w_down,
            "ab_w_in": ab_w_in, "ab_w_out": ab_w_out, "q_norm_gain": q_norm_gain,
            "k_norm_gain": k_norm_gain, "attn_sinks": attn_sinks, "pool_w": pool_w,
            "pool_scale": pool_scale, "c_w_in": c_w_in, "c_w_out": c_w_out,
            "c_out_norm_gain": c_out_norm_gain, "lb_logits": lb_logits}


def reference(x, positions, norm_gains, ffn_w_gate, ffn_w_up, ffn_w_down,
              ab_w_in, ab_w_out, q_norm_gain, k_norm_gain, attn_sinks, pool_w,
              pool_scale, c_w_in, c_w_out, c_out_norm_gain, lb_logits):
    P = jax.nn.softmax(lb_logits.astype(jnp.float32), axis=0)
    lower_bounds = jnp.cumsum(P, axis=0) - P[0]
    for layer in range(DEPTH):
        h = rms_norm(x, norm_gains[layer, 0])
        x = x + 0.5 * swiglu(h, ffn_w_gate[layer, 0], ffn_w_up[layer, 0], ffn_w_down[layer, 0])
        h = rms_norm(x, norm_gains[layer, 1])
        j = layer // 2
        if layer % 2 == 0:
            x = x + attn_pool_mixer(h, positions, ab_w_in[j], ab_w_out[j], q_norm_gain[j],
                                    k_norm_gain[j], attn_sinks[j], pool_w[j], pool_scale[j])
        else:
            x = x + hgrn_mixer(h, c_w_in[j], c_w_out[j], c_out_norm_gain[j], lower_bounds[j])
        h = rms_norm(x, norm_gains[layer, 2])
        x = x + 0.5 * swiglu(h, ffn_w_gate[layer, 1], ffn_w_up[layer, 1], ffn_w_down[layer, 1])
    return x
```

```cpp
#include <hip/hip_runtime.h>
#include <hip/hip_cooperative_groups.h>
#include <cstdio>
namespace cg = cooperative_groups;

#ifndef REP_MIX
#define REP_MIX 1
#endif
#ifndef ONE_LAUNCH
#define ONE_LAUNCH 1
#endif

#define LAS __attribute__((address_space(3)))
typedef unsigned short bf16_t;
typedef short bf16x8 __attribute__((ext_vector_type(8)));
typedef short bf16x4 __attribute__((ext_vector_type(4)));
typedef float f32x4 __attribute__((ext_vector_type(4)));
typedef float f32x2 __attribute__((ext_vector_type(2)));
typedef unsigned u32x4 __attribute__((ext_vector_type(4)));
typedef unsigned u32x2 __attribute__((ext_vector_type(2)));
typedef _Float16 f16x2_t __attribute__((ext_vector_type(2)));
typedef _Float16 f16x4_t __attribute__((ext_vector_type(4)));
typedef _Float16 f16x8_t __attribute__((ext_vector_type(8)));

constexpr int MTOK = 65536, DM = 1024, DFF = 2816, SEQ = 2048, NB = 32;
constexpr int AB_IN = 1280, HG_IN = 4096;
constexpr int LDS_BYTES = 131072 + 4096;

constexpr size_t MiB = 1024ull * 1024ull;
constexpr size_t WS_XB = 0;
constexpr size_t WS_ACT = 128 * MiB;
constexpr size_t WS_CAT = 640 * MiB;
constexpr size_t WS_WGU = 768 * MiB;
constexpr size_t WS_WDN = 856 * MiB;
constexpr size_t WS_WABIN = 900 * MiB;
constexpr size_t WS_WABOUT = 905 * MiB;
constexpr size_t WS_WCIN = 909 * MiB;
constexpr size_t WS_WCOUT = 925 * MiB;
constexpr size_t WS_POOLW = 929 * MiB;
constexpr size_t WS_ROWSS = 930 * MiB;
constexpr size_t WS_ROPE = 938 * MiB;
constexpr size_t WS_LB = 939 * MiB;
constexpr size_t WS_BAR = 940 * MiB;
constexpr size_t WS_END = 941 * MiB;

constexpr int NPHASE_K = 29;
struct Params {
    const float* x; const int* pos; const float* ng; const float* wg; const float* wu; const float* wd;
    const float* abin; const float* about; const float* qg; const float* kg; const float* sinks; const float* poolw; const float* pools;
    const float* cin; const float* cout; const float* cog; const float* lbl;
    float* out; unsigned char* ws; int lo, hi;
};

__device__ __forceinline__ float bf2f(unsigned short b) { return __uint_as_float(((unsigned)b) << 16); }
typedef __bf16 bf16x2_t __attribute__((ext_vector_type(2)));
__device__ __forceinline__ unsigned cvt_pk_bf16(float lo, float hi) { f32x2 v = {lo, hi}; bf16x2_t r = __builtin_convertvector(v, bf16x2_t); return __builtin_bit_cast(unsigned, r); }
__device__ __forceinline__ unsigned cvt_pk_f16(float lo, float hi) { f32x2 v = {lo, hi}; f16x2_t r = __builtin_convertvector(v, f16x2_t); return __builtin_bit_cast(unsigned, r); }
__device__ __forceinline__ bf16_t f2bf(float f) { return (bf16_t)(cvt_pk_bf16(f, 0.f) & 0xffffu); }
__device__ __forceinline__ bf16x8 pack8(float a0, float a1, float a2, float a3, float a4, float a5, float a6, float a7) {
    u32x4 w; w.x = cvt_pk_bf16(a0, a1); w.y = cvt_pk_bf16(a2, a3); w.z = cvt_pk_bf16(a4, a5); w.w = cvt_pk_bf16(a6, a7); return __builtin_bit_cast(bf16x8, w); }
__device__ __forceinline__ float fast_exp(float x) { return __builtin_amdgcn_exp2f(x * 1.4426950408889634f); }
__device__ __forceinline__ float fast_sigmoid(float x) { return __builtin_amdgcn_rcpf(1.0f + fast_exp(-x)); }
#define MFMA16(a, b, c) __builtin_amdgcn_mfma_f32_16x16x32_bf16((a), (b), (c), 0, 0, 0)

namespace pg8 {
constexpr int BM = 256, BK = 64, HALF = 128, HTB = HALF * BK * 2, STAGE_BYTES = 8 * HTB, NXCD = 8, WGM = 8;
__device__ __forceinline__ int lds_byte(int r, int c) { const int st = (r >> 4) * 2 + (c >> 5), rr = r & 15, cc = c & 31, ob = rr * 64 + cc * 2; return st * 1024 + (ob ^ (((ob >> 9) & 1) << 5)); }
__device__ __forceinline__ void stage_rc(int b, int& R, int& C) { const int st = b / 1024, sb = b % 1024, swz = sb ^ (((sb >> 9) & 1) << 5); R = (st >> 1) * 16 + swz / 64; C = (st & 1) * 32 + (swz % 64) / 2; }
__device__ __forceinline__ int perm32(int rho) { const int n = rho >> 4, i = rho & 15; return 8 * (i >> 2) + 4 * n + (i & 3); }
struct Unit { int pm, pn; };
struct Gemm { const bf16_t* A; const bf16_t* Bt; int M, N, K; };
struct StaticOrder {
    int nM, nN, nwg, G, c, rev;
    __device__ void init(int M, int N, int G_, int c_, int rev_ = 0) { nM = M / BM; nN = N / BM; nwg = nM * nN; G = G_; c = c_; rev = rev_; }
    __device__ bool next(int i, Unit& u) const {
        long L = (long)i * G + c; if (L >= nwg) return false;
        if (rev) L = nwg - 1 - L;
        int wgid = (int)L; { const int q = nwg / NXCD, r = nwg % NXCD, xcd = wgid % NXCD, off = wgid / NXCD; wgid = (xcd < r ? xcd * (q + 1) : r * (q + 1) + (xcd - r) * q) + off; }
        const int nig = WGM * nN, gid = wgid / nig, fm = gid * WGM, gsz = (nM - fm) < WGM ? (nM - fm) : WGM;
        u.pm = fm + ((wgid % nig) % gsz); u.pn = (wgid % nig) / gsz; return true;
    }
};

template <class Epi, bool F16 = false>
__device__ __forceinline__ void gemm_phase(LAS unsigned char* lds, const Gemm g, const StaticOrder& S, const Epi& E) {
    int tid_ = threadIdx.x; asm volatile("" : "+v"(tid_));
    const int tid = tid_, wid = __builtin_amdgcn_readfirstlane(tid >> 6), lane = tid & 63, wr = wid >> 2, wc = wid & 3, fr = lane & 15, fq = lane >> 4;
    const int K = g.K, nt = K / BK;
    unsigned voffA[2], voffB[2];
#pragma unroll
    for (int i = 0; i < 2; ++i) { int R, C; stage_rc(tid * 16 + i * 8192, R, C); const int Rb = Epi::PERM ? ((R & ~31) + perm32(R & 31)) : R;
        voffA[i] = (unsigned)(R * K + C) * 2u; voffB[i] = (unsigned)(Rb * K + C) * 2u; }
    const size_t kstep = (size_t)(BK * 2);
    const size_t hstep = (size_t)HALF * K * 2;
    const size_t tstep = 2 * hstep;
    const unsigned ldsw = (unsigned)wid * 1024u;
    const int aoff = lds_byte(wr * 64 + fr, fq * 8), boff = lds_byte(wc * 32 + fr, fq * 8);
#define PG8_SA(b, h) (((b) * 2 + (h)) * HTB)
#define PG8_SB(b, h) ((4 + (b) * 2 + (h)) * HTB)
#define PG8_STAGE(bufoff, gbase, voff) do { _Pragma("unroll") for (int _i = 0; _i < 2; ++_i) \
        __builtin_amdgcn_global_load_lds((const unsigned*)((const char*)(gbase) + (voff)[_i]), (LAS unsigned*)(lds + (bufoff) + ldsw + _i * 8192), 16, 0, 0); } while (0)
#define PG8_LDA(dst, b, h) do { _Pragma("unroll") for (int m = 0; m < 4; ++m) _Pragma("unroll") for (int k = 0; k < 2; ++k) dst[m][k] = *(const LAS bf16x8*)(lds + PG8_SA(b, h) + aoff + m * 2048 + k * 1024); } while (0)
#define PG8_LDB(dst, b, h) do { _Pragma("unroll") for (int n = 0; n < 2; ++n) _Pragma("unroll") for (int k = 0; k < 2; ++k) dst[n][k] = *(const LAS bf16x8*)(lds + PG8_SB(b, h) + boff + n * 2048 + k * 1024); } while (0)
#define PG8_MMA(ai, bj, At, Bt) do { __builtin_amdgcn_s_setprio(1); _Pragma("unroll") for (int m = 0; m < 4; ++m) _Pragma("unroll") for (int n = 0; n < 2; ++n) _Pragma("unroll") for (int k = 0; k < 2; ++k) \
        acc[ai][bj][m][n] = F16 ? __builtin_amdgcn_mfma_f32_16x16x32_f16(__builtin_bit_cast(f16x8_t, Bt[n][k]), __builtin_bit_cast(f16x8_t, At[m][k]), acc[ai][bj][m][n], 0, 0, 0) \
                                : __builtin_amdgcn_mfma_f32_16x16x32_bf16(Bt[n][k], At[m][k], acc[ai][bj][m][n], 0, 0, 0); __builtin_amdgcn_s_setprio(0); } while (0)
#define PG8_WAIT_V(n) asm volatile("s_waitcnt vmcnt(" #n ")" ::: "memory")
#define PG8_WAIT_L(n) asm volatile("s_waitcnt lgkmcnt(" #n ")" ::: "memory")
#define PG8_BAR __builtin_amdgcn_s_barrier()
#define PG8_SCHED __builtin_amdgcn_sched_barrier(0)
    Unit cur, nxt; int ui = 0;
    if (!S.next(0, cur)) return;
    f32x4 acc[2][2][4][2];
#pragma unroll
    for (int a = 0; a < 2; ++a)
#pragma unroll
        for (int b = 0; b < 2; ++b)
#pragma unroll
            for (int m = 0; m < 4; ++m)
#pragma unroll
                for (int n = 0; n < 2; ++n) acc[a][b][m][n] = (f32x4){0.f, 0.f, 0.f, 0.f};
    bf16x8 At[4][2], B0[2][2], B1[2][2];
    typename Epi::Pre pre; E.prefetch(pre, cur, wr, fr);
    const char* cA = (const char*)g.A + (size_t)cur.pm * tstep; const char* cB = (const char*)g.Bt + (size_t)cur.pn * tstep;
    PG8_STAGE(PG8_SB(0, 0), cB, voffB); PG8_STAGE(PG8_SA(0, 0), cA, voffA); PG8_STAGE(PG8_SB(0, 1), cB + hstep, voffB); PG8_STAGE(PG8_SA(0, 1), cA + hstep, voffA);
    if (wr == 1) PG8_BAR;
    PG8_WAIT_V(4); PG8_BAR;
    PG8_STAGE(PG8_SB(1, 0), cB + kstep, voffB); PG8_STAGE(PG8_SA(1, 0), cA + kstep, voffA); PG8_STAGE(PG8_SB(1, 1), cB + hstep + kstep, voffB);
    PG8_WAIT_V(6); PG8_BAR;
    for (;;) {
        const bool has_next = S.next(ui + 1, nxt);
        const char* nA = has_next ? (const char*)g.A + (size_t)nxt.pm * tstep : cA; const char* nB = has_next ? (const char*)g.Bt + (size_t)nxt.pn * tstep : cB;
        for (int t = 0; t < nt; t += 2) {
            const bool last = (t == nt - 2);
            const char* a1 = cA + (size_t)(t + 1) * kstep;
            const char* a2 = last ? nA : cA + (size_t)(t + 2) * kstep; const char* b2 = last ? nB : cB + (size_t)(t + 2) * kstep;
            const char* a3 = a2 + kstep; const char* b3 = b2 + kstep;
            PG8_LDB(B0, 0, 0); PG8_SCHED; PG8_LDA(At, 0, 0); PG8_STAGE(PG8_SA(1, 1), a1 + hstep, voffA);
            PG8_WAIT_L(8); PG8_BAR; PG8_WAIT_L(0); PG8_MMA(0, 0, At, B0); PG8_BAR; PG8_SCHED;
            PG8_LDB(B1, 0, 1); PG8_STAGE(PG8_SB(0, 0), b2, voffB);
            PG8_BAR; PG8_WAIT_L(0); PG8_MMA(0, 1, At, B1); PG8_BAR;
            PG8_LDA(At, 0, 1); PG8_STAGE(PG8_SA(0, 0), a2, voffA);
            PG8_BAR; PG8_WAIT_L(0); PG8_MMA(1, 0, At, B0); PG8_BAR; PG8_SCHED;
            PG8_STAGE(PG8_SB(0, 1), b2 + hstep, voffB);
            PG8_WAIT_V(6); PG8_BAR; PG8_MMA(1, 1, At, B1); PG8_BAR;
            PG8_LDB(B0, 1, 0); PG8_SCHED; PG8_LDA(At, 1, 0); PG8_STAGE(PG8_SA(0, 1), a2 + hstep, voffA);
            PG8_WAIT_L(8); PG8_BAR; PG8_WAIT_L(0); PG8_MMA(0, 0, At, B0); PG8_BAR; PG8_SCHED;
            PG8_LDB(B1, 1, 1); PG8_STAGE(PG8_SB(1, 0), b3, voffB);
            PG8_BAR; PG8_WAIT_L(0); PG8_MMA(0, 1, At, B1); PG8_BAR;
            PG8_LDA(At, 1, 1); PG8_STAGE(PG8_SA(1, 0), a3, voffA);
            PG8_BAR; PG8_WAIT_L(0); PG8_MMA(1, 0, At, B0); PG8_BAR; PG8_SCHED;
            PG8_STAGE(PG8_SB(1, 1), b3 + hstep, voffB);
            PG8_WAIT_V(6); PG8_BAR; PG8_MMA(1, 1, At, B1); PG8_BAR;
        }
        E(acc, pre, cur, wr, wc, fr, fq);
        if (!has_next) break;
        E.prefetch(pre, nxt, wr, fr);
#pragma unroll
        for (int a = 0; a < 2; ++a)
#pragma unroll
            for (int b = 0; b < 2; ++b)
#pragma unroll
                for (int m = 0; m < 4; ++m)
#pragma unroll
                    for (int n = 0; n < 2; ++n) acc[a][b][m][n] = (f32x4){0.f, 0.f, 0.f, 0.f};
        cur = nxt; cA = nA; cB = nB; ++ui;
    }
    PG8_WAIT_V(0);
    if (wr == 0) PG8_BAR;
    PG8_BAR;
#undef PG8_SA
#undef PG8_SB
#undef PG8_STAGE
#undef PG8_LDA
#undef PG8_LDB
#undef PG8_MMA
#undef PG8_WAIT_V
#undef PG8_WAIT_L
#undef PG8_BAR
#undef PG8_SCHED
}
}

struct EpiSwiglu {
    static constexpr bool PERM = true;
    bf16_t* O; const unsigned* rowss;
    struct Pre { unsigned v[8]; };
    __device__ __forceinline__ void prefetch(Pre& pre, const pg8::Unit& u, int wr, int fr) const {
        const unsigned* rp = rowss + u.pm * 256 + wr * 64 + fr;
#pragma unroll
        for (int i = 0; i < 8; ++i) pre.v[i] = rp[(i >> 2) * 128 + (i & 3) * 16]; }
    __device__ __forceinline__ void operator()(const f32x4 (&acc)[2][2][4][2], const Pre& pre, const pg8::Unit& u, int wr, int wc, int fr, int fq) const {
        const int row0 = u.pm * 256 + wr * 64 + fr, h0 = u.pn * 128 + wc * 32 + 8 * fq;
#pragma unroll
        for (int ai = 0; ai < 2; ++ai)
#pragma unroll
            for (int m = 0; m < 4; ++m) {
                const int r = row0 + ai * 128 + m * 16;
                const float rs = __builtin_amdgcn_rsqf((float)pre.v[ai * 4 + m] * (1.0f / (1024.0f * 1024.0f)) + 1e-6f);
                float o[8];
#pragma unroll
                for (int n = 0; n < 2; ++n)
#pragma unroll
                    for (int j = 0; j < 4; ++j) { const float gv = acc[ai][0][m][n][j] * rs, uv = acc[ai][1][m][n][j] * rs; o[n * 4 + j] = gv * uv * fast_sigmoid(gv); }
                u32x4 w; w.x = cvt_pk_bf16(o[0], o[1]); w.y = cvt_pk_bf16(o[2], o[3]); w.z = cvt_pk_bf16(o[4], o[5]); w.w = cvt_pk_bf16(o[6], o[7]);
                *(u32x4*)(O + (size_t)r * DFF + h0) = w;
            }
    }
};
struct EpiProj {
    static constexpr bool PERM = true;
    bf16_t* O; int ldc; const unsigned* rowss;
    struct Pre { unsigned v[8]; };
    __device__ __forceinline__ void prefetch(Pre& pre, const pg8::Unit& u, int wr, int fr) const {
        const unsigned* rp = rowss + u.pm * 256 + wr * 64 + fr;
#pragma unroll
        for (int i = 0; i < 8; ++i) pre.v[i] = rp[(i >> 2) * 128 + (i & 3) * 16]; }
    __device__ __forceinline__ void operator()(const f32x4 (&acc)[2][2][4][2], const Pre& pre, const pg8::Unit& u, int wr, int wc, int fr, int fq) const {
        const int row0 = u.pm * 256 + wr * 64 + fr, col0 = u.pn * 256 + wc * 32 + 8 * fq;
#pragma unroll
        for (int ai = 0; ai < 2; ++ai)
#pragma unroll
            for (int m = 0; m < 4; ++m) {
                const int r = row0 + ai * 128 + m * 16;
                const float rs = __builtin_amdgcn_rsqf((float)pre.v[ai * 4 + m] * (1.0f / (1024.0f * 1024.0f)) + 1e-6f);
#pragma unroll
                for (int bj = 0; bj < 2; ++bj) {
                    const f32x4 v0 = acc[ai][bj][m][0] * rs, v1 = acc[ai][bj][m][1] * rs;
                    u32x4 w; w.x = cvt_pk_bf16(v0[0], v0[1]); w.y = cvt_pk_bf16(v0[2], v0[3]); w.z = cvt_pk_bf16(v1[0], v1[1]); w.w = cvt_pk_bf16(v1[2], v1[3]);
                    *(u32x4*)(O + (size_t)r * ldc + col0 + bj * 128) = w;
                }
            }
    }
};
template <bool FINAL> struct EpiResid {
    static constexpr bool PERM = true;
    const _Float16* xin; _Float16* xout; float* outf; bf16_t* xb; unsigned* rowss_next; float scale; LAS unsigned char* lds;
    struct Pre { };
    __device__ __forceinline__ void prefetch(Pre&, const pg8::Unit&, int, int) const {}
    __device__ __forceinline__ void operator()(const f32x4 (&acc)[2][2][4][2], const Pre&, const pg8::Unit& u, int wr, int wc, int fr, int fq) const {
        const int row0 = u.pm * 256 + wr * 64 + fr, col0 = u.pn * 256 + wc * 32 + 8 * fq;
        f16x8_t xc[2][4][2];
#pragma unroll
        for (int m = 0; m < 4; ++m) { const _Float16* xp = xin + (size_t)(row0 + m * 16) * DM + col0;
#pragma unroll
            for (int bj = 0; bj < 2; ++bj) xc[0][m][bj] = *(const f16x8_t*)(xp + bj * 128); }
#pragma unroll
        for (int m = 0; m < 2; ++m) { const _Float16* xp = xin + (size_t)(row0 + 128 + m * 16) * DM + col0;
#pragma unroll
            for (int bj = 0; bj < 2; ++bj) xc[1][m][bj] = *(const f16x8_t*)(xp + bj * 128); }
        asm volatile("" ::: "memory");
#pragma unroll
        for (int ai = 0; ai < 2; ++ai)
#pragma unroll
            for (int m = 0; m < 4; ++m) {
                if (ai == 0 && m == 1) {
#pragma unroll
                    for (int m2 = 2; m2 < 4; ++m2) { const _Float16* xp = xin + (size_t)(row0 + 128 + m2 * 16) * DM + col0;
#pragma unroll
                        for (int bj = 0; bj < 2; ++bj) xc[1][m2][bj] = *(const f16x8_t*)(xp + bj * 128); }
                }
                const int r = row0 + ai * 128 + m * 16; const size_t off = (size_t)r * DM + col0; float ss = 0.f;
#pragma unroll
                for (int bj = 0; bj < 2; ++bj) {
                    const f16x8_t xv = xc[ai][m][bj];
                    const f32x4 x0 = {(float)xv[0], (float)xv[1], (float)xv[2], (float)xv[3]}, x1 = {(float)xv[4], (float)xv[5], (float)xv[6], (float)xv[7]};
                    const f32x4 o0 = x0 + acc[ai][bj][m][0] * scale, o1 = x1 + acc[ai][bj][m][1] * scale;
                    if (FINAL) { *(f32x4*)(outf + off + bj * 128) = o0; *(f32x4*)(outf + off + bj * 128 + 4) = o1; }
                    else {
                        const f16x4_t h0 = __builtin_convertvector(o0, f16x4_t), h1 = __builtin_convertvector(o1, f16x4_t);
                        const f16x8_t hv = {h0[0], h0[1], h0[2], h0[3], h1[0], h1[1], h1[2], h1[3]};
                        *(f16x8_t*)(xout + off + bj * 128) = hv;
                        ss += (o0[0] * o0[0] + o0[1] * o0[1]) + (o0[2] * o0[2] + o0[3] * o0[3]) + (o1[0] * o1[0] + o1[1] * o1[1]) + (o1[2] * o1[2] + o1[3] * o1[3]);
                    }
                }
                if (!FINAL) { ss += __shfl_xor(ss, 16); ss += __shfl_xor(ss, 32);
                    if (fq == 0) ((LAS float*)(lds + 131072))[((wr * 4 + wc) * 8 + ai * 4 + m) * 16 + fr] = ss; }
            }
        if (!FINAL) {
            asm volatile("s_waitcnt lgkmcnt(0)" ::: "memory"); __builtin_amdgcn_s_barrier(); asm volatile("" ::: "memory");
            if (wc == 0) {
                const int lane = fq * 16 + fr;
#pragma unroll
                for (int hh = 0; hh < 2; ++hh) {
                    const int idx = hh * 64 + lane, g = idx >> 4, f = idx & 15;
                    float t = 0.f;
#pragma unroll
                    for (int w4 = 0; w4 < 4; ++w4) t += ((const LAS float*)(lds + 131072))[((wr * 4 + w4) * 8 + g) * 16 + f];
                    atomicAdd(rowss_next + u.pm * 256 + (g >> 2) * 128 + wr * 64 + (g & 3) * 16 + f, (unsigned)(t * 1024.0f + 0.5f));
                }
            }
        }
    }
};

__device__ __forceinline__ void get_job(const Params& P, int id, const float*& src, bf16_t*& dst, const float*& gain, int& K, int& N, int& mode) {
    unsigned char* ws = P.ws; gain = nullptr; mode = 0;
    if (id < 16) { const int which = id >> 3, ls = id & 7, l = ls >> 1, s = ls & 1;
        src = (which ? P.wu : P.wg) + (size_t)ls * DM * DFF; dst = (bf16_t*)(ws + WS_WGU) + (size_t)ls * 2 * DFF * DM; gain = P.ng + (l * 3 + (s ? 2 : 0)) * DM; K = DM; N = DFF; mode = 1 + which; }
    else if (id < 24) { const int ls = id - 16; src = P.wd + (size_t)ls * DFF * DM; dst = (bf16_t*)(ws + WS_WDN) + (size_t)ls * DFF * DM; K = DFF; N = DM; }
    else if (id < 26) { const int j = id - 24; src = P.abin + (size_t)j * DM * AB_IN; dst = (bf16_t*)(ws + WS_WABIN) + (size_t)j * DM * AB_IN; gain = P.ng + ((2 * j) * 3 + 1) * DM; K = DM; N = AB_IN; }
    else if (id < 28) { const int j = id - 26; src = P.about + (size_t)j * DM * DM; dst = (bf16_t*)(ws + WS_WABOUT) + (size_t)j * DM * DM; K = DM; N = DM; }
    else if (id < 30) { const int j = id - 28; src = P.cin + (size_t)j * DM * HG_IN; dst = (bf16_t*)(ws + WS_WCIN) + (size_t)j * DM * HG_IN; gain = P.ng + ((2 * j + 1) * 3 + 1) * DM; K = DM; N = HG_IN; }
    else if (id < 32) { const int j = id - 30; src = P.cout + (size_t)j * DM * DM; dst = (bf16_t*)(ws + WS_WCOUT) + (size_t)j * DM * DM; K = DM; N = DM; }
    else { const int j = id - 32; src = P.poolw + (size_t)j * 128 * 128; dst = (bf16_t*)(ws + WS_POOLW) + (size_t)j * 128 * 128; K = 128; N = 128; }
}

__device__ void phase0(LAS unsigned char* lds, const Params& P) {
    int tid_ = threadIdx.x; asm volatile("" : "+v"(tid_));
    const int tid = tid_, lane = tid & 63, wave = tid >> 6, G = gridDim.x, bid = blockIdx.x;
    LAS float* tile = (LAS float*)lds;
    for (int id = 0; id < 40; ++id) {
        const float* src; bf16_t* dst; const float* gain; int K, N, mode;
        get_job(P, id, src, dst, gain, K, N, mode);
        const int ntn = N >> 6, ntiles = (K >> 6) * ntn;
        for (int t = bid; t < ntiles; t += G) {
            const int k0 = (t / ntn) << 6, n0 = (t % ntn) << 6;
#pragma unroll
            for (int p = 0; p < 2; ++p) { const int idx = p * 512 + tid, kk = idx >> 4, n4 = (idx & 15) * 4;
                f32x4 v = *(const f32x4*)(src + (size_t)(k0 + kk) * N + n0 + n4); if (gain) v *= gain[k0 + kk];
                tile[kk * 65 + n4] = v[0]; tile[kk * 65 + n4 + 1] = v[1]; tile[kk * 65 + n4 + 2] = v[2]; tile[kk * 65 + n4 + 3] = v[3]; }
            __syncthreads();
#pragma unroll
            for (int p = 0; p < 4; ++p) { const int idx = p * 512 + tid, nn = idx >> 5, kk = (idx & 31) * 2, n = n0 + nn;
                const int drow = mode == 0 ? n : ((n >> 7) * 256 + (n & 127) + (mode == 2 ? 128 : 0));
                const float w0 = tile[kk * 65 + nn], w1 = tile[(kk + 1) * 65 + nn];
                *(unsigned*)(dst + (size_t)drow * K + k0 + kk) = gain ? cvt_pk_f16(w0, w1) : cvt_pk_bf16(w0, w1); }
            __syncthreads();
        }
    }
    bf16_t* xb = (bf16_t*)(P.ws + WS_XB); unsigned* rowss = (unsigned*)(P.ws + WS_ROWSS);
    for (int row0 = (bid * 8 + wave) * 2; row0 < MTOK; row0 += G * 16) {
        f32x4 v[2][4];
#pragma unroll
        for (int rr = 0; rr < 2; ++rr)
#pragma unroll
            for (int i = 0; i < 4; ++i) v[rr][i] = ((const f32x4*)(P.x + (size_t)(row0 + rr) * DM))[lane + 64 * i];
#pragma unroll
        for (int rr = 0; rr < 2; ++rr) { float s = 0.f;
#pragma unroll
            for (int i = 0; i < 4; ++i) { const f32x4 t = v[rr][i]; s += (t[0] * t[0] + t[1] * t[1]) + (t[2] * t[2] + t[3] * t[3]);
                *(f16x4_t*)((_Float16*)P.out + (size_t)(row0 + rr) * DM + 4 * (lane + 64 * i)) = __builtin_convertvector(t, f16x4_t); }
#pragma unroll
            for (int o = 32; o >= 1; o >>= 1) s += __shfl_xor(s, o);
            if (lane == 0) rowss[row0 + rr] = (unsigned)(s * 1024.0f + 0.5f); }
    }
    for (int i = bid * 512 + tid; i < 11 * MTOK; i += G * 512) rowss[MTOK + i] = 0u;
    f32x2* rope = (f32x2*)(P.ws + WS_ROPE);
    for (int i = bid * 512 + tid; i < SEQ * 32; i += G * 512) {
        const int t = i >> 5, fi = i & 31;
        const float inv = exp2f(-(float)fi * (13.287712379549449f / 32.0f));
        const float ang = (float)P.pos[t] * inv;
        const double rev = (double)ang * 0.15915494309189535; const float fr = (float)(rev - floor(rev));
        rope[i] = (f32x2){__builtin_amdgcn_cosf(fr), __builtin_amdgcn_sinf(fr)};
    }
    float* lb = (float*)(P.ws + WS_LB);
    for (int i = bid * 512 + tid; i < 1024; i += G * 512) { const float l0 = P.lbl[i], l1 = P.lbl[1024 + i]; const float mx = fmaxf(l0, l1);
        const float e0 = expf(l0 - mx), e1 = expf(l1 - mx); const float p0 = e0 / (e0 + e1), p1 = e1 / (e0 + e1); lb[i] = p0 - p0; lb[1024 + i] = (p0 + p1) - p0; }
}

constexpr int KS_STRIDE = 72;
constexpr int VT_STRIDE = 264;
constexpr int ATT_KS_OFF = 0, ATT_VT_OFF = 256 * KS_STRIDE * 2;
constexpr int POOL_US_OFF = 0, POOL_DS_OFF = 144 * 128 * 2, POOL_W_OFF = POOL_DS_OFF + 128 * 136 * 2;

__device__ __forceinline__ void rope8r(bf16x8 a, bf16x8 c, float rs, const float* g, const f32x2* ropep, int fi0, bf16x8& r1, bf16x8& r2) {
    float o1[8], o2[8];
#pragma unroll
    for (int e = 0; e < 8; ++e) { const f32x2 cs = ropep[fi0 + e];
        const float y1 = bf2f((unsigned short)a[e]) * rs * g[fi0 + e], y2 = bf2f((unsigned short)c[e]) * rs * g[32 + fi0 + e]; o1[e] = y1 * cs.x - y2 * cs.y; o2[e] = y2 * cs.x + y1 * cs.y; }
    r1 = pack8(o1[0], o1[1], o1[2], o1[3], o1[4], o1[5], o1[6], o1[7]); r2 = pack8(o2[0], o2[1], o2[2], o2[3], o2[4], o2[5], o2[6], o2[7]);
}
__device__ __forceinline__ void rope8(bf16x8 a, bf16x8 c, float rs, const float* g, const f32x2* ropep, int fi0, LAS bf16_t* d1, LAS bf16_t* d2) {
    bf16x8 r1, r2; rope8r(a, c, rs, g, ropep, fi0, r1, r2); *(LAS bf16x8*)d1 = r1; *(LAS bf16x8*)d2 = r2;
}
__device__ void attn_pool_phase(LAS unsigned char* lds, const Params& P, int j, int rev) {
    int tid_ = threadIdx.x; asm volatile("" : "+v"(tid_));
    const int tid = tid_, lane = tid & 63, wave = __builtin_amdgcn_readfirstlane(tid >> 6), li = lane & 15, lh = lane >> 4;
    const bf16_t* proj = (const bf16_t*)(P.ws + WS_ACT);
    bf16_t* cat = (bf16_t*)(P.ws + WS_CAT);
    const f32x2* rope = (const f32x2*)(P.ws + WS_ROPE);
    const float* qg = P.qg + j * 64; const float* kg = P.kg + j * 64;
    LAS bf16_t* Ks = (LAS bf16_t*)(lds + ATT_KS_OFF); LAS bf16_t* Vt = (LAS bf16_t*)(lds + ATT_VT_OFF);
    for (int item0 = blockIdx.x; item0 < 512; item0 += gridDim.x) {
        const int item = rev ? 511 - item0 : item0;
        const int b = item >> 4, blk = item & 15; const int tok0 = b * SEQ + blk * 128;
        for (int kh = 0; kh < 2; ++kh) {
            __syncthreads();
            {
                const int key = tid >> 1, p = tid & 1; const int tpos = blk * 128 - 128 + key;
                LAS bf16_t* krow = Ks + key * KS_STRIDE;
                if (tpos >= 0) {
                    const bf16_t* kp = proj + (size_t)(b * SEQ + tpos) * AB_IN + 512 + 64 * kh;
                    const bf16x8 a0 = *(const bf16x8*)(kp + 16 * p), a1 = *(const bf16x8*)(kp + 16 * p + 8), c0 = *(const bf16x8*)(kp + 32 + 16 * p), c1 = *(const bf16x8*)(kp + 32 + 16 * p + 8);
                    float ss = 0.f;
#pragma unroll
                    for (int e = 0; e < 8; ++e) { const float u0 = bf2f((unsigned short)a0[e]), u1 = bf2f((unsigned short)a1[e]), u2 = bf2f((unsigned short)c0[e]), u3 = bf2f((unsigned short)c1[e]); ss += (u0 * u0 + u1 * u1) + (u2 * u2 + u3 * u3); }
                    ss += __shfl_xor(ss, 1);
                    const float rs = __builtin_amdgcn_rsqf(ss * (1.0f / 64.0f) + 1e-6f);
                    rope8(a0, c0, rs, kg, rope + tpos * 32, 16 * p, krow + 16 * p, krow + 32 + 16 * p);
                    asm volatile("" ::: "memory");
                    rope8(a1, c1, rs, kg, rope + tpos * 32, 16 * p + 8, krow + 16 * p + 8, krow + 32 + 16 * p + 8);
                    asm volatile("" ::: "memory");
                    const bf16_t* vp = proj + (size_t)(b * SEQ + tpos) * AB_IN + 640 + 64 * kh + 32 * p;
#pragma unroll
                    for (int q4 = 0; q4 < 4; ++q4) { const bf16x8 vv = *(const bf16x8*)(vp + 8 * q4);
#pragma unroll
                        for (int e = 0; e < 8; ++e) Vt[(32 * p + 8 * q4 + e) * VT_STRIDE + key] = (bf16_t)vv[e];
                        if (q4 & 1) asm volatile("" ::: "memory"); }
                } else {
                    const bf16x8 z = {0, 0, 0, 0, 0, 0, 0, 0};
                    *(LAS bf16x8*)(krow + 16 * p) = z; *(LAS bf16x8*)(krow + 16 * p + 8) = z; *(LAS bf16x8*)(krow + 32 + 16 * p) = z; *(LAS bf16x8*)(krow + 32 + 16 * p + 8) = z;
#pragma unroll
                    for (int e = 0; e < 32; ++e) Vt[(32 * p + e) * VT_STRIDE + key] = 0;
                }
            }
            const int hq = wave & 1, hd = 4 * kh + (wave >> 1);
            __syncthreads();
            const float sink2 = P.sinks[j * 8 + hd] * 1.4426950408889634f;
            for (int qs = 0; qs < 2; ++qs) {
            const int q0 = 64 * hq + 32 * qs;
            bf16x8 Qf[2][2];
#pragma unroll
            for (int m = 0; m < 2; ++m) {
                const int ql = q0 + 16 * m + li; const int tpos = blk * 128 + ql;
                const bf16_t* qp = proj + (size_t)(tok0 + ql) * AB_IN + 64 * hd + 8 * lh;
                const bf16x8 a = *(const bf16x8*)qp, c = *(const bf16x8*)(qp + 32);
                float ss = 0.f;
#pragma unroll
                for (int e = 0; e < 8; ++e) { const float u0 = bf2f((unsigned short)a[e]), u1 = bf2f((unsigned short)c[e]); ss += u0 * u0 + u1 * u1; }
                ss += __shfl_xor(ss, 16); ss += __shfl_xor(ss, 32);
                const float rs = __builtin_amdgcn_rsqf(ss * (1.0f / 64.0f) + 1e-6f) * (0.125f * 1.4426950408889634f);
                rope8r(a, c, rs, qg, rope + tpos * 32, 8 * lh, Qf[m][0], Qf[m][1]);
                asm volatile("" ::: "memory");
            }
            float mrow[2], lrow[2];
            f32x4 ot[4][2];
#pragma unroll
            for (int m = 0; m < 2; ++m) { mrow[m] = sink2; lrow[m] = 1.0f;
#pragma unroll
                for (int dm = 0; dm < 4; ++dm) ot[dm][m] = (f32x4){0.f, 0.f, 0.f, 0.f}; }
            for (int kt = hq; kt < hq + 3; ++kt) {
                if (blk == 0 && kt < 2) continue;
                f32x4 st[4][2];
#pragma unroll
                for (int n = 0; n < 4; ++n) {
                    const LAS bf16_t* kr = Ks + (64 * kt + 16 * n + li) * KS_STRIDE + 8 * lh;
                    const bf16x8 k0 = *(const LAS bf16x8*)kr, k1 = *(const LAS bf16x8*)(kr + 32);
#pragma unroll
                    for (int m = 0; m < 2; ++m) { f32x4 a = (f32x4){0.f, 0.f, 0.f, 0.f}; a = MFMA16(k0, Qf[m][0], a); a = MFMA16(k1, Qf[m][1], a); st[n][m] = a; }
                }
#pragma unroll
                for (int m = 0; m < 2; ++m) {
                    const int r = q0 + 16 * m + li;
                    float mx = -INFINITY;
#pragma unroll
                    for (int n = 0; n < 4; ++n)
#pragma unroll
                        for (int e = 0; e < 4; ++e) { const int c = 64 * kt + 16 * n + 4 * lh + e; const bool ok = (c > r) && (c <= r + 128);
                            const float s = ok ? st[n][m][e] : -INFINITY; st[n][m][e] = s; mx = fmaxf(mx, s); }
                    mx = fmaxf(mx, __shfl_xor(mx, 16)); mx = fmaxf(mx, __shfl_xor(mx, 32));
                    const float mn = fmaxf(mrow[m], mx); const float alpha = __builtin_amdgcn_exp2f(mrow[m] - mn); mrow[m] = mn;
                    float ls = 0.f;
#pragma unroll
                    for (int n = 0; n < 4; ++n)
#pragma unroll
                        for (int e = 0; e < 4; ++e) { const float pv = __builtin_amdgcn_exp2f(st[n][m][e] - mn); st[n][m][e] = pv; ls += pv; }
                    ls += __shfl_xor(ls, 16); ls += __shfl_xor(ls, 32);
                    lrow[m] = lrow[m] * alpha + ls;
#pragma unroll
                    for (int dm = 0; dm < 4; ++dm) ot[dm][m] *= alpha;
                }
#pragma unroll
                for (int ks = 0; ks < 2; ++ks) {
                    bf16x8 Pf[2];
#pragma unroll
                    for (int m = 0; m < 2; ++m) Pf[m] = pack8(st[2 * ks][m][0], st[2 * ks][m][1], st[2 * ks][m][2], st[2 * ks][m][3], st[2 * ks + 1][m][0], st[2 * ks + 1][m][1], st[2 * ks + 1][m][2], st[2 * ks + 1][m][3]);
#pragma unroll
                    for (int dm = 0; dm < 4; ++dm) {
                        const LAS bf16_t* vr = Vt + (16 * dm + li) * VT_STRIDE + 64 * kt + 32 * ks + 4 * lh;
                        const bf16x4 v0 = *(const LAS bf16x4*)vr, v1 = *(const LAS bf16x4*)(vr + 16);
                        const bf16x8 Vf = {v0[0], v0[1], v0[2], v0[3], v1[0], v1[1], v1[2], v1[3]};
#pragma unroll
                        for (int m = 0; m < 2; ++m) ot[dm][m] = MFMA16(Vf, Pf[m], ot[dm][m]);
                    }
                }
            }
#pragma unroll
            for (int m = 0; m < 2; ++m) {
                const float inv = 1.0f / lrow[m]; const int ql = q0 + 16 * m + li;
                bf16_t* op = cat + (size_t)(tok0 + ql) * DM + 64 * hd + 4 * lh;
#pragma unroll
                for (int dm = 0; dm < 4; ++dm) { const f32x4 o = ot[dm][m] * inv; u32x2 w; w.x = cvt_pk_bf16(o[0], o[1]); w.y = cvt_pk_bf16(o[2], o[3]); *(u32x2*)(op + 16 * dm) = w; }
            }
            }
        }
        LAS bf16_t* Us = (LAS bf16_t*)(lds + POOL_US_OFF); LAS bf16_t* Ds = (LAS bf16_t*)(lds + POOL_DS_OFF); LAS bf16_t* Wp = (LAS bf16_t*)(lds + POOL_W_OFF);
        for (int g = 0; g < 4; ++g) {
            const int w = 2 << g;
            __syncthreads();
            for (int ch = tid; ch < 144 * 16; ch += 512) { const int rr = ch >> 4, c8 = (ch & 15) * 8; const int ts = blk * 128 - 16 + rr;
                bf16x8 v = {0, 0, 0, 0, 0, 0, 0, 0};
                if (ts >= 0) v = *(const bf16x8*)(proj + (size_t)(b * SEQ + ts) * AB_IN + 768 + 128 * g + c8);
                *(LAS bf16x8*)(Us + rr * 128 + c8) = v; }
            { const bf16_t* wsrc = (const bf16_t*)(P.ws + WS_POOLW) + (size_t)(j * 4 + g) * 128 * 128;
              for (int ch = tid; ch < 128 * 16; ch += 512) { const int n = ch >> 4, c8 = (ch & 15) * 8; *(LAS bf16x8*)(Wp + n * 136 + c8) = *(const bf16x8*)(wsrc + n * 128 + c8); } }
            __syncthreads();
            { const int c = tid & 127, tq = tid >> 7; const int t0 = tq * 32;
              float s = 0.f;
              for (int jj = 0; jj < w; ++jj) s += bf2f(Us[(16 + t0 - jj) * 128 + c]);
              for (int t = t0; t < t0 + 32; ++t) {
                  const float ut = bf2f(Us[(16 + t) * 128 + c]);
                  const int cnt = min(blk * 128 + t + 1, w);
                  Ds[t * 136 + c] = f2bf(s / (float)cnt - ut);
                  if (t + 1 < t0 + 32) s += bf2f(Us[(16 + t + 1) * 128 + c]) - bf2f(Us[(16 + t + 1 - w) * 128 + c]);
              } }
            __syncthreads();
            {
                f32x4 pa[8];
#pragma unroll
                for (int nf = 0; nf < 8; ++nf) pa[nf] = (f32x4){0.f, 0.f, 0.f, 0.f};
#pragma unroll
                for (int ks = 0; ks < 4; ++ks) {
                    const bf16x8 df = *(const LAS bf16x8*)(Ds + (16 * wave + li) * 136 + 32 * ks + 8 * lh);
#pragma unroll
                    for (int nf = 0; nf < 8; ++nf) { const bf16x8 wf = *(const LAS bf16x8*)(Wp + (16 * nf + li) * 136 + 32 * ks + 8 * lh); pa[nf] = MFMA16(wf, df, pa[nf]); }
                }
                const float* psc = P.pools + j * 512 + 128 * g;
                bf16_t* op = cat + (size_t)(tok0 + 16 * wave + li) * DM + 512 + 128 * g + 4 * lh;
#pragma unroll
                for (int nf = 0; nf < 8; ++nf) { const f32x4 sc = *(const f32x4*)(psc + 16 * nf + 4 * lh); const f32x4 o = pa[nf] * sc;
                    u32x2 wv; wv.x = cvt_pk_bf16(o[0], o[1]); wv.y = cvt_pk_bf16(o[2], o[3]); *(u32x2*)(op + 16 * nf) = wv; }
            }
        }
    }
    __syncthreads();
}

constexpr int HG_A1 = 0, HG_AP = 8704, HG_BP = 17408, HG_KDT = 26112, HG_VT = 36352, HG_ST = 46592, HG_SC = 81408, HG_TOT = 83968, HG_RED = 86016;

__device__ void hgrn_phase(LAS unsigned char* lds, const Params& P, int j, int rev) {
    int tid_ = threadIdx.x; asm volatile("" : "+v"(tid_));
    const int tid = tid_, lane = tid & 63, wave = __builtin_amdgcn_readfirstlane(tid >> 6), li = lane & 15, lh = lane >> 4;
    const bf16_t* proj = (const bf16_t*)(P.ws + WS_ACT);
    bf16_t* cat = (bf16_t*)(P.ws + WS_CAT);
    LAS bf16_t* A1s = (LAS bf16_t*)(lds + HG_A1); LAS bf16_t* Aps = (LAS bf16_t*)(lds + HG_AP); LAS bf16_t* Bps = (LAS bf16_t*)(lds + HG_BP);
    LAS bf16_t* KdT = (LAS bf16_t*)(lds + HG_KDT); LAS bf16_t* VT = (LAS bf16_t*)(lds + HG_VT); LAS bf16_t* St = (LAS bf16_t*)(lds + HG_ST);
    LAS bf16_t* Sc = (LAS bf16_t*)(lds + HG_SC); LAS float* tot = (LAS float*)(lds + HG_TOT); LAS float* red = (LAS float*)(lds + HG_RED);
    const int kc = tid & 127, tg = tid >> 7;
    for (int item0 = blockIdx.x; item0 < 256; item0 += gridDim.x) {
        const int item = rev ? 255 - item0 : item0;
        const int b = item >> 3, h = item & 7;
        const float lb = ((const float*)(P.ws + WS_LB))[j * 1024 + h * 128 + kc];
        f32x4 og4 = *(const f32x4*)(P.cog + j * 128 + 16 * wave + 4 * lh);
        __syncthreads();
        for (int i = tid; i < 128 * 136 / 2; i += 512) ((LAS unsigned*)St)[i] = 0u;
        f32x4 Sacc[8];
#pragma unroll
        for (int vf = 0; vf < 8; ++vf) Sacc[vf] = (f32x4){0.f, 0.f, 0.f, 0.f};
        unsigned short rq[8], rf[8], ri[8];
        { const bf16_t* p0 = proj + (size_t)(b * SEQ + 8 * tg) * HG_IN + h * 128 + kc;
#pragma unroll
          for (int e = 0; e < 8; ++e) { rq[e] = p0[(size_t)e * HG_IN]; rf[e] = p0[(size_t)e * HG_IN + 1024]; ri[e] = p0[(size_t)e * HG_IN + 2048]; } }
        for (int c = 0; c < 64; ++c) {
            const size_t crow = (size_t)(b * SEQ + 32 * c);
            float cs[8], kk[8], qt[8];
            { float run = 0.f;
#pragma unroll
              for (int e = 0; e < 8; ++e) { const float z = bf2f(rf[e]); const float sg = fast_sigmoid(z); const float f = lb + (1.0f - lb) * sg;
                  run += __logf(fmaxf(f, 1e-6f)); cs[e] = run; kk[e] = 1.0f - f; const float qv = bf2f(rq[e]); qt[e] = qv * fast_sigmoid(qv); }
              tot[tg * 128 + kc] = run; }
            bf16x4 gt[2];
#pragma unroll
            for (int m = 0; m < 2; ++m) gt[m] = *(const bf16x4*)(proj + (crow + 16 * m + li) * HG_IN + 3072 + h * 128 + 16 * wave + 4 * lh);
            __syncthreads();
            { const float t0 = tot[kc], t1 = tot[128 + kc], t2 = tot[256 + kc], t3 = tot[384 + kc];
              const float pre = (tg > 0 ? t0 : 0.f) + (tg > 1 ? t1 : 0.f) + (tg > 2 ? t2 : 0.f);
              const float gm = t0 + t1, gl = gm + t2 + t3;
              float kd[8], vv[8];
#pragma unroll
              for (int e = 0; e < 8; ++e) { const float G = pre + cs[e]; const int t = 8 * tg + e;
                  A1s[t * 136 + kc] = f2bf(qt[e] * fast_exp(G)); Aps[t * 136 + kc] = f2bf(qt[e] * fast_exp(G - gm)); Bps[t * 136 + kc] = f2bf(kk[e] * fast_exp(gm - G));
                  kd[e] = kk[e] * fast_exp(gl - G); vv[e] = bf2f(ri[e]); }
              *(LAS bf16x8*)(KdT + kc * 40 + 8 * tg) = pack8(kd[0], kd[1], kd[2], kd[3], kd[4], kd[5], kd[6], kd[7]);
              *(LAS bf16x8*)(VT + kc * 40 + 8 * tg) = pack8(vv[0], vv[1], vv[2], vv[3], vv[4], vv[5], vv[6], vv[7]); }
            if (c + 1 < 64) { const bf16_t* p0 = proj + (crow + 32 + 8 * tg) * HG_IN + h * 128 + kc;
#pragma unroll
              for (int e = 0; e < 8; ++e) { rq[e] = p0[(size_t)e * HG_IN]; rf[e] = p0[(size_t)e * HG_IN + 1024]; ri[e] = p0[(size_t)e * HG_IN + 2048]; } }
            __syncthreads();
            float dec[4];
#pragma unroll
            for (int e = 0; e < 4; ++e) { const int k = 16 * wave + 4 * lh + e; dec[e] = fast_exp(tot[k] + tot[128 + k] + tot[256 + k] + tot[384 + k]); }
            f32x4 oacc[2] = {(f32x4){0.f, 0.f, 0.f, 0.f}, (f32x4){0.f, 0.f, 0.f, 0.f}};
#pragma unroll
            for (int ks = 0; ks < 4; ++ks) {
                const bf16x8 sf = *(const LAS bf16x8*)(St + (16 * wave + li) * 136 + 32 * ks + 8 * lh);
#pragma unroll
                for (int m = 0; m < 2; ++m) { const bf16x8 af = *(const LAS bf16x8*)(A1s + (16 * m + li) * 136 + 32 * ks + 8 * lh); oacc[m] = MFMA16(sf, af, oacc[m]); }
            }
            if (wave < 3) {
                const int sfr = (wave == 2) ? 1 : 0, tfr = (wave == 0) ? 0 : 1;
                f32x4 sa = (f32x4){0.f, 0.f, 0.f, 0.f};
#pragma unroll
                for (int ks = 0; ks < 4; ++ks) { const bf16x8 bf = *(const LAS bf16x8*)(Bps + (16 * sfr + li) * 136 + 32 * ks + 8 * lh); const bf16x8 af = *(const LAS bf16x8*)(Aps + (16 * tfr + li) * 136 + 32 * ks + 8 * lh); sa = MFMA16(bf, af, sa); }
                const int t = 16 * tfr + li;
                float sv[4];
#pragma unroll
                for (int e = 0; e < 4; ++e) { const int s = 16 * sfr + 4 * lh + e; sv[e] = (s <= t) ? sa[e] : 0.f; }
                u32x2 w; w.x = cvt_pk_bf16(sv[0], sv[1]); w.y = cvt_pk_bf16(sv[2], sv[3]); *(LAS u32x2*)(Sc + t * 40 + 16 * sfr + 4 * lh) = w;
            } else if (wave == 3) { u32x2 w; w.x = 0u; w.y = 0u; *(LAS u32x2*)(Sc + li * 40 + 16 + 4 * lh) = w; }
            __syncthreads();
            { const bf16x8 vf = *(const LAS bf16x8*)(VT + (16 * wave + li) * 40 + 8 * lh);
#pragma unroll
              for (int m = 0; m < 2; ++m) { const bf16x8 sf = *(const LAS bf16x8*)(Sc + (16 * m + li) * 40 + 8 * lh); oacc[m] = MFMA16(vf, sf, oacc[m]); } }
#pragma unroll
            for (int m = 0; m < 2; ++m) { float ss = 0.f;
#pragma unroll
                for (int e = 0; e < 4; ++e) { const float o = oacc[m][e] * fast_sigmoid(bf2f((unsigned short)gt[m][e])); oacc[m][e] = o; ss += o * o; }
                ss += __shfl_xor(ss, 16); ss += __shfl_xor(ss, 32);
                if (lh == 0) red[wave * 32 + 16 * m + li] = ss; }
            __syncthreads();
#pragma unroll
            for (int m = 0; m < 2; ++m) { const int t = 16 * m + li; float ss = 0.f;
#pragma unroll
                for (int w8 = 0; w8 < 8; ++w8) ss += red[w8 * 32 + t];
                const float rs = __builtin_amdgcn_rsqf(ss * (1.0f / 128.0f) + 1e-6f);
                const f32x4 o = oacc[m] * rs * og4; u32x2 w; w.x = cvt_pk_bf16(o[0], o[1]); w.y = cvt_pk_bf16(o[2], o[3]);
                *(u32x2*)(cat + (crow + t) * DM + h * 128 + 16 * wave + 4 * lh) = w; }
            { const bf16x8 kf = *(const LAS bf16x8*)(KdT + (16 * wave + li) * 40 + 8 * lh);
#pragma unroll
              for (int vf = 0; vf < 8; ++vf) { const bf16x8 vfr = *(const LAS bf16x8*)(VT + (16 * vf + li) * 40 + 8 * lh);
                  f32x4 s = Sacc[vf]; s[0] *= dec[0]; s[1] *= dec[1]; s[2] *= dec[2]; s[3] *= dec[3];
                  s = MFMA16(kf, vfr, s); Sacc[vf] = s;
                  u32x2 w; w.x = cvt_pk_bf16(s[0], s[1]); w.y = cvt_pk_bf16(s[2], s[3]); *(LAS u32x2*)(St + (16 * vf + li) * 136 + 16 * wave + 4 * lh) = w; } }
        }
    }
    __syncthreads();
}


__device__ __forceinline__ void grid_barrier(unsigned* bar, unsigned k) {
    asm volatile("s_waitcnt vmcnt(0)" ::: "memory");
    __syncthreads();
    if (threadIdx.x == 0) {
        const unsigned ngrp = 8u, gsz = gridDim.x / ngrp, g = blockIdx.x % ngrp;
        __builtin_amdgcn_fence(__ATOMIC_RELEASE, "agent");
        asm volatile("s_waitcnt vmcnt(0)" ::: "memory");
        const unsigned old = __hip_atomic_fetch_add(bar + 64 * g, 1u, __ATOMIC_RELAXED, __HIP_MEMORY_SCOPE_AGENT);
        if (old + 1u == gsz * k) __hip_atomic_fetch_add(bar + 64 * ngrp, 1u, __ATOMIC_RELAXED, __HIP_MEMORY_SCOPE_AGENT);
        while (__hip_atomic_load(bar + 64 * ngrp, __ATOMIC_RELAXED, __HIP_MEMORY_SCOPE_AGENT) < ngrp * k) __builtin_amdgcn_s_sleep(1);
        __builtin_amdgcn_fence(__ATOMIC_ACQUIRE, "agent");
        asm volatile("s_waitcnt vmcnt(0)" ::: "memory");
    }
    __syncthreads();
}
__global__ void __launch_bounds__(512, 2) mega(Params P) {
    extern __shared__ __attribute__((aligned(16))) unsigned char lds_raw[];
    LAS unsigned char* lds = (LAS unsigned char*)lds_raw;
    cg::grid_group grid = cg::this_grid();
    unsigned char* ws = P.ws;
    bf16_t* xb = (bf16_t*)(ws + WS_XB); bf16_t* act = (bf16_t*)(ws + WS_ACT); bf16_t* cat = (bf16_t*)(ws + WS_CAT); unsigned* rowss = (unsigned*)(ws + WS_ROWSS);
    for (int p = P.lo; p < P.hi; ++p) {
        const bf16_t* xhA = (const bf16_t*)((p > NPHASE_K - 3) ? (ws + WS_ACT + 384 * MiB) : (unsigned char*)P.out);
        if (p > P.lo) { if (p == P.lo + 1) grid.sync(); else grid_barrier((unsigned*)(ws + WS_BAR), (unsigned)(p - P.lo - 1)); }
        if (p == 0) { phase0(lds, P); continue; }
        const int q = p - 1, layer = q / 7, step = q % 7, jj = layer >> 1; const bool even = (layer & 1) == 0;
        pg8::StaticOrder S;
        if (step == 0 || step == 5) {
            const int s = step == 0 ? 0 : 1;
            pg8::Gemm g{xhA, (const bf16_t*)(ws + WS_WGU) + (size_t)(layer * 2 + s) * 2 * DFF * DM, MTOK, 2 * DFF, DM}; S.init(MTOK, 2 * DFF, gridDim.x, blockIdx.x, p & 1);
            EpiSwiglu E{act, rowss + (size_t)(layer * 3 + (s ? 2 : 0)) * MTOK};
            pg8::gemm_phase<EpiSwiglu, true>(lds, g, S, E);
        } else if (step == 2) {
            const int N = even ? AB_IN : HG_IN;
            const bf16_t* W = even ? (const bf16_t*)(ws + WS_WABIN) + (size_t)jj * DM * AB_IN : (const bf16_t*)(ws + WS_WCIN) + (size_t)jj * DM * HG_IN;
            pg8::Gemm g{xhA, W, MTOK, N, DM}; S.init(MTOK, N, gridDim.x, blockIdx.x, p & 1);
            EpiProj E{act, N, rowss + (size_t)(layer * 3 + 1) * MTOK};
            pg8::gemm_phase<EpiProj, true>(lds, g, S, E);
        } else if (step == 3) {
            for (int rep = 0; rep < REP_MIX; ++rep) { if (even) attn_pool_phase(lds, P, jj, p & 1); else hgrn_phase(lds, P, jj, p & 1); }
        } else {
            const bf16_t* A; const bf16_t* W; int K; float scale; int nid;
            if (step == 4) { A = cat; W = even ? (const bf16_t*)(ws + WS_WABOUT) + (size_t)jj * DM * DM : (const bf16_t*)(ws + WS_WCOUT) + (size_t)jj * DM * DM; K = DM; scale = 1.0f; nid = layer * 3 + 2; }
            else { const int s = step == 1 ? 0 : 1; A = act; W = (const bf16_t*)(ws + WS_WDN) + (size_t)(layer * 2 + s) * DFF * DM; K = DFF; scale = 0.5f; nid = s ? (layer + 1) * 3 : layer * 3 + 1; }
            pg8::Gemm g{A, W, MTOK, DM, K}; S.init(MTOK, DM, gridDim.x, blockIdx.x, p & 1);
            _Float16* xh_main = (_Float16*)P.out; _Float16* xh_alt = (_Float16*)(ws + WS_ACT + 384 * MiB);
            if (p == NPHASE_K - 1) { EpiResid<true> E{xh_alt, nullptr, P.out, nullptr, nullptr, scale, lds}; pg8::gemm_phase<EpiResid<true>>(lds, g, S, E); }
            else { EpiResid<false> E{xh_main, (p == NPHASE_K - 3) ? xh_alt : xh_main, nullptr, xb, rowss + (size_t)nid * MTOK, scale, lds}; pg8::gemm_phase<EpiResid<false>>(lds, g, S, E); }
        }
    }
}

constexpr int NPHASE = 29;
#ifndef NRUN
#define NRUN 29
#endif

extern "C" void kernel_launch(void* const* d_in, const int* in_sizes, int n_in, void* d_out, int out_size, void* d_ws, size_t ws_size, hipStream_t stream) {
    static int grid = 0;
    if (grid == 0) {
        if (n_in != 17 || out_size != MTOK * DM || ws_size < WS_END) { fprintf(stderr, "kernel_launch: unexpected shapes (n_in %d out %d ws %zu)\n", n_in, out_size, ws_size); grid = -1; return; }
        int dev = 0, cus = 0, per_cu = 0;
        hipGetDevice(&dev); hipDeviceGetAttribute(&cus, hipDeviceAttributeMultiprocessorCount, dev);
        if (hipFuncSetAttribute((const void*)mega, hipFuncAttributeMaxDynamicSharedMemorySize, LDS_BYTES) != hipSuccess) { fprintf(stderr, "kernel_launch: hipFuncSetAttribute failed\n"); grid = -1; return; }
        if (hipOccupancyMaxActiveBlocksPerMultiprocessor(&per_cu, (const void*)mega, 512, LDS_BYTES) != hipSuccess || per_cu < 1) { fprintf(stderr, "kernel_launch: occupancy query says %d\n", per_cu); per_cu = 1; }
        (void)hipGetLastError();
        grid = cus;
    }
    if (grid < 0) return;
    Params p{};
    p.x = (const float*)d_in[0]; p.pos = (const int*)d_in[1]; p.ng = (const float*)d_in[2]; p.wg = (const float*)d_in[3]; p.wu = (const float*)d_in[4]; p.wd = (const float*)d_in[5];
    p.abin = (const float*)d_in[6]; p.about = (const float*)d_in[7]; p.qg = (const float*)d_in[8]; p.kg = (const float*)d_in[9]; p.sinks = (const float*)d_in[10];
    p.poolw = (const float*)d_in[11]; p.pools = (const float*)d_in[12]; p.cin = (const float*)d_in[13]; p.cout = (const float*)d_in[14]; p.cog = (const float*)d_in[15]; p.lbl = (const float*)d_in[16];
    p.out = (float*)d_out; p.ws = (unsigned char*)d_ws;
#if ONE_LAUNCH
    p.lo = 0; p.hi = NPHASE;
    (void)hipMemsetAsync((unsigned char*)d_ws + WS_BAR, 0, 9 * 256, stream);
    void* args[] = {&p};
    hipError_t e = hipLaunchCooperativeKernel((const void*)mega, dim3(grid), dim3(512), args, LDS_BYTES, stream);
    if (e != hipSuccess) fprintf(stderr, "cooperative launch failed: %s (grid %d)\n", hipGetErrorString(e), grid);
#else
    for (int ph = 0; ph < NRUN; ++ph) { p.lo = ph; p.hi = ph + 1; hipLaunchKernelGGL(mega, dim3(grid), dim3(512), LDS_BYTES, stream, p); }
#endif
}
```

```cpp
#include <hip/hip_runtime.h>
#include <hip/hip_cooperative_groups.h>
#include <cstdio>
namespace cg = cooperative_groups;

#ifndef REP_MIX
#define REP_MIX 1
#endif
#ifndef ONE_LAUNCH
#define ONE_LAUNCH 1
#endif

#define LAS __attribute__((address_space(3)))
typedef unsigned short bf16_t;
typedef short bf16x8 __attribute__((ext_vector_type(8)));
typedef short bf16x4 __attribute__((ext_vector_type(4)));
typedef float f32x4 __attribute__((ext_vector_type(4)));
typedef float f32x2 __attribute__((ext_vector_type(2)));
typedef unsigned u32x4 __attribute__((ext_vector_type(4)));
typedef unsigned u32x2 __attribute__((ext_vector_type(2)));
typedef _Float16 f16x2_t __attribute__((ext_vector_type(2)));
typedef _Float16 f16x4_t __attribute__((ext_vector_type(4)));
typedef _Float16 f16x8_t __attribute__((ext_vector_type(8)));

constexpr int MTOK = 65536, DM = 1024, DFF = 2816, SEQ = 2048, NB = 32;
constexpr int AB_IN = 1280, HG_IN = 4096;
constexpr int LDS_BYTES = 131072 + 4096 + 2048;

constexpr size_t MiB = 1024ull * 1024ull;
constexpr size_t WS_XB = 0;
constexpr size_t WS_ACT = 128 * MiB;
constexpr size_t WS_CAT = 640 * MiB;
constexpr size_t WS_WGU = 768 * MiB;
constexpr size_t WS_WDN = 856 * MiB;
constexpr size_t WS_WABIN = 900 * MiB;
constexpr size_t WS_WABOUT = 905 * MiB;
constexpr size_t WS_WCIN = 909 * MiB;
constexpr size_t WS_WCOUT = 925 * MiB;
constexpr size_t WS_POOLW = 929 * MiB;
constexpr size_t WS_ROWSS = 930 * MiB;
constexpr size_t WS_ROPE = 938 * MiB;
constexpr size_t WS_LB = 939 * MiB;
constexpr size_t WS_BAR = 940 * MiB;
constexpr size_t WS_END = 941 * MiB;

constexpr int NPHASE_K = 29;
struct Params {
    const float* x; const int* pos; const float* ng; const float* wg; const float* wu; const float* wd;
    const float* abin; const float* about; const float* qg; const float* kg; const float* sinks; const float* poolw; const float* pools;
    const float* cin; const float* cout; const float* cog; const float* lbl;
    float* out; unsigned char* ws; int lo, hi;
};

__device__ __forceinline__ float bf2f(unsigned short b) { return __uint_as_float(((unsigned)b) << 16); }
typedef __bf16 bf16x2_t __attribute__((ext_vector_type(2)));
__device__ __forceinline__ unsigned cvt_pk_bf16(float lo, float hi) { f32x2 v = {lo, hi}; bf16x2_t r = __builtin_convertvector(v, bf16x2_t); return __builtin_bit_cast(unsigned, r); }
__device__ __forceinline__ unsigned cvt_pk_f16(float lo, float hi) { f32x2 v = {lo, hi}; f16x2_t r = __builtin_convertvector(v, f16x2_t); return __builtin_bit_cast(unsigned, r); }
__device__ __forceinline__ bf16_t f2bf(float f) { return (bf16_t)(cvt_pk_bf16(f, 0.f) & 0xffffu); }
__device__ __forceinline__ bf16x8 pack8(float a0, float a1, float a2, float a3, float a4, float a5, float a6, float a7) {
    u32x4 w; w.x = cvt_pk_bf16(a0, a1); w.y = cvt_pk_bf16(a2, a3); w.z = cvt_pk_bf16(a4, a5); w.w = cvt_pk_bf16(a6, a7); return __builtin_bit_cast(bf16x8, w); }
__device__ __forceinline__ float fast_exp(float x) { return __builtin_amdgcn_exp2f(x * 1.4426950408889634f); }
__device__ __forceinline__ float fast_sigmoid(float x) { return __builtin_amdgcn_rcpf(1.0f + fast_exp(-x)); }
#define MFMA16(a, b, c) __builtin_amdgcn_mfma_f32_16x16x32_bf16((a), (b), (c), 0, 0, 0)

namespace pg8 {
constexpr int BM = 256, BK = 64, HALF = 128, HTB = HALF * BK * 2, STAGE_BYTES = 8 * HTB, NXCD = 8, WGM = 8;
__device__ __forceinline__ int lds_byte(int r, int c) { const int st = (r >> 4) * 2 + (c >> 5), rr = r & 15, cc = c & 31, ob = rr * 64 + cc * 2; return st * 1024 + (ob ^ (((ob >> 9) & 1) << 5)); }
__device__ __forceinline__ void stage_rc(int b, int& R, int& C) { const int st = b / 1024, sb = b % 1024, swz = sb ^ (((sb >> 9) & 1) << 5); R = (st >> 1) * 16 + swz / 64; C = (st & 1) * 32 + (swz % 64) / 2; }
__device__ __forceinline__ int perm32(int rho) { const int n = rho >> 4, i = rho & 15; return 8 * (i >> 2) + 4 * n + (i & 3); }
struct Unit { int pm, pn; };
struct Gemm { const bf16_t* A; const bf16_t* Bt; int M, N, K; };
struct StaticOrder {
    int nM, nN, nwg, G, c, rev;
    __device__ void init(int M, int N, int G_, int c_, int rev_ = 0) { nM = M / BM; nN = N / BM; nwg = nM * nN; G = G_; c = c_; rev = rev_; }
    __device__ bool next(int i, Unit& u) const {
        long L = (long)i * G + c; if (L >= nwg) return false;
        if (rev) L = nwg - 1 - L;
        int wgid = (int)L; { const int q = nwg / NXCD, r = nwg % NXCD, xcd = wgid % NXCD, off = wgid / NXCD; wgid = (xcd < r ? xcd * (q + 1) : r * (q + 1) + (xcd - r) * q) + off; }
        const int nig = WGM * nN, gid = wgid / nig, fm = gid * WGM, gsz = (nM - fm) < WGM ? (nM - fm) : WGM;
        u.pm = fm + ((wgid % nig) % gsz); u.pn = (wgid % nig) / gsz; return true;
    }
};

template <class Epi, bool F16 = false>
__device__ __forceinline__ void gemm_phase(LAS unsigned char* lds, const Gemm g, const StaticOrder& S, const Epi& E) {
    int tid_ = threadIdx.x; asm volatile("" : "+v"(tid_));
    const int tid = tid_, wid = __builtin_amdgcn_readfirstlane(tid >> 6), lane = tid & 63, wr = wid >> 2, wc = wid & 3, fr = lane & 15, fq = lane >> 4;
    const int K = g.K, nt = K / BK;
    unsigned voffA[2], voffB[2];
#pragma unroll
    for (int i = 0; i < 2; ++i) { int R, C; stage_rc(tid * 16 + i * 8192, R, C); const int Rb = Epi::PERM ? ((R & ~31) + perm32(R & 31)) : R;
        voffA[i] = (unsigned)(R * K + C) * 2u; voffB[i] = (unsigned)(Rb * K + C) * 2u; }
    const size_t kstep = (size_t)(BK * 2);
    const size_t hstep = (size_t)HALF * K * 2;
    const size_t tstep = 2 * hstep;
    const unsigned ldsw = (unsigned)wid * 1024u;
    const int aoff = lds_byte(wr * 64 + fr, fq * 8), boff = lds_byte(wc * 32 + fr, fq * 8);
#define PG8_SA(b, h) (((b) * 2 + (h)) * HTB)
#define PG8_SB(b, h) ((4 + (b) * 2 + (h)) * HTB)
#define PG8_STAGE(bufoff, gbase, voff) do { _Pragma("unroll") for (int _i = 0; _i < 2; ++_i) \
        __builtin_amdgcn_global_load_lds((const unsigned*)((const char*)(gbase) + (voff)[_i]), (LAS unsigned*)(lds + (bufoff) + ldsw + _i * 8192), 16, 0, 0); } while (0)
#define PG8_LDA(dst, b, h) do { _Pragma("unroll") for (int m = 0; m < 4; ++m) _Pragma("unroll") for (int k = 0; k < 2; ++k) dst[m][k] = *(const LAS bf16x8*)(lds + PG8_SA(b, h) + aoff + m * 2048 + k * 1024); } while (0)
#define PG8_LDB(dst, b, h) do { _Pragma("unroll") for (int n = 0; n < 2; ++n) _Pragma("unroll") for (int k = 0; k < 2; ++k) dst[n][k] = *(const LAS bf16x8*)(lds + PG8_SB(b, h) + boff + n * 2048 + k * 1024); } while (0)
#define PG8_MMA(ai, bj, At, Bt) do { __builtin_amdgcn_s_setprio(1); _Pragma("unroll") for (int m = 0; m < 4; ++m) _Pragma("unroll") for (int n = 0; n < 2; ++n) _Pragma("unroll") for (int k = 0; k < 2; ++k) \
        acc[ai][bj][m][n] = F16 ? __builtin_amdgcn_mfma_f32_16x16x32_f16(__builtin_bit_cast(f16x8_t, Bt[n][k]), __builtin_bit_cast(f16x8_t, At[m][k]), acc[ai][bj][m][n], 0, 0, 0) \
                                : __builtin_amdgcn_mfma_f32_16x16x32_bf16(Bt[n][k], At[m][k], acc[ai][bj][m][n], 0, 0, 0); __builtin_amdgcn_s_setprio(0); } while (0)
#define PG8_WAIT_V(n) asm volatile("s_waitcnt vmcnt(" #n ")" ::: "memory")
#define PG8_WAIT_L(n) asm volatile("s_waitcnt lgkmcnt(" #n ")" ::: "memory")
#define PG8_BAR __builtin_amdgcn_s_barrier()
#define PG8_SCHED __builtin_amdgcn_sched_barrier(0)
    Unit cur, nxt; int ui = 0;
    if (!S.next(0, cur)) return;
    f32x4 acc[2][2][4][2];
#pragma unroll
    for (int a = 0; a < 2; ++a)
#pragma unroll
        for (int b = 0; b < 2; ++b)
#pragma unroll
            for (int m = 0; m < 4; ++m)
#pragma unroll
                for (int n = 0; n < 2; ++n) acc[a][b][m][n] = (f32x4){0.f, 0.f, 0.f, 0.f};
    bf16x8 At[4][2], B0[2][2], B1[2][2];
    typename Epi::Pre pre; LAS unsigned char* const pretab = lds + 131072 + 4096;
    E.prefetch_lds(pretab, cur, wid, lane);
    const char* cA = (const char*)g.A + (size_t)cur.pm * tstep; const char* cB = (const char*)g.Bt + (size_t)cur.pn * tstep;
    PG8_STAGE(PG8_SB(0, 0), cB, voffB); PG8_STAGE(PG8_SA(0, 0), cA, voffA); PG8_STAGE(PG8_SB(0, 1), cB + hstep, voffB); PG8_STAGE(PG8_SA(0, 1), cA + hstep, voffA);
    if (wr == 1) PG8_BAR;
    PG8_WAIT_V(4); PG8_BAR;
    PG8_STAGE(PG8_SB(1, 0), cB + kstep, voffB); PG8_STAGE(PG8_SA(1, 0), cA + kstep, voffA); PG8_STAGE(PG8_SB(1, 1), cB + hstep + kstep, voffB);
    PG8_WAIT_V(6); PG8_BAR;
    for (;;) {
        const bool has_next = S.next(ui + 1, nxt);
        const char* nA = has_next ? (const char*)g.A + (size_t)nxt.pm * tstep : cA; const char* nB = has_next ? (const char*)g.Bt + (size_t)nxt.pn * tstep : cB;
        for (int t = 0; t < nt; t += 2) {
            const bool last = (t == nt - 2);
            const char* a1 = cA + (size_t)(t + 1) * kstep;
            const char* a2 = last ? nA : cA + (size_t)(t + 2) * kstep; const char* b2 = last ? nB : cB + (size_t)(t + 2) * kstep;
            const char* a3 = a2 + kstep; const char* b3 = b2 + kstep;
            PG8_LDB(B0, 0, 0); PG8_SCHED; PG8_LDA(At, 0, 0); PG8_STAGE(PG8_SA(1, 1), a1 + hstep, voffA);
            PG8_WAIT_L(8); PG8_BAR; PG8_WAIT_L(0); PG8_MMA(0, 0, At, B0); PG8_BAR; PG8_SCHED;
            PG8_LDB(B1, 0, 1); PG8_STAGE(PG8_SB(0, 0), b2, voffB);
            PG8_BAR; PG8_WAIT_L(0); PG8_MMA(0, 1, At, B1); PG8_BAR;
            PG8_LDA(At, 0, 1); PG8_STAGE(PG8_SA(0, 0), a2, voffA);
            PG8_BAR; PG8_WAIT_L(0); PG8_MMA(1, 0, At, B0); PG8_BAR; PG8_SCHED;
            PG8_STAGE(PG8_SB(0, 1), b2 + hstep, voffB);
            PG8_WAIT_V(6); PG8_BAR; PG8_MMA(1, 1, At, B1); PG8_BAR;
            PG8_LDB(B0, 1, 0); PG8_SCHED; PG8_LDA(At, 1, 0); PG8_STAGE(PG8_SA(0, 1), a2 + hstep, voffA);
            PG8_WAIT_L(8); PG8_BAR; PG8_WAIT_L(0); PG8_MMA(0, 0, At, B0); PG8_BAR; PG8_SCHED;
            PG8_LDB(B1, 1, 1); PG8_STAGE(PG8_SB(1, 0), b3, voffB);
            PG8_BAR; PG8_WAIT_L(0); PG8_MMA(0, 1, At, B1); PG8_BAR;
            PG8_LDA(At, 1, 1); PG8_STAGE(PG8_SA(1, 0), a3, voffA);
            PG8_BAR; PG8_WAIT_L(0); PG8_MMA(1, 0, At, B0); PG8_BAR; PG8_SCHED;
            PG8_STAGE(PG8_SB(1, 1), b3 + hstep, voffB);
            PG8_WAIT_V(6); PG8_BAR; PG8_MMA(1, 1, At, B1); PG8_BAR;
        }
        E.fetch_pre(pre, pretab + (ui & 1) * 1024, wr, fr);
        E(acc, pre, cur, wr, wc, fr, fq);
        if (!has_next) break;
        E.prefetch_lds(pretab + ((ui + 1) & 1) * 1024, nxt, wid, lane);
#pragma unroll
        for (int a = 0; a < 2; ++a)
#pragma unroll
            for (int b = 0; b < 2; ++b)
#pragma unroll
                for (int m = 0; m < 4; ++m)
#pragma unroll
                    for (int n = 0; n < 2; ++n) acc[a][b][m][n] = (f32x4){0.f, 0.f, 0.f, 0.f};
        cur = nxt; cA = nA; cB = nB; ++ui;
    }
    PG8_WAIT_V(0);
    if (wr == 0) PG8_BAR;
    PG8_BAR;
#undef PG8_SA
#undef PG8_SB
#undef PG8_STAGE
#undef PG8_LDA
#undef PG8_LDB
#undef PG8_MMA
#undef PG8_WAIT_V
#undef PG8_WAIT_L
#undef PG8_BAR
#undef PG8_SCHED
}
}

struct EpiSwiglu {
    static constexpr bool PERM = true;
    bf16_t* O; const unsigned* rowss;
    struct Pre { unsigned v[8]; };
    static constexpr bool LDS_PRE = true;
    __device__ __forceinline__ void prefetch_lds(LAS unsigned char* tab, const pg8::Unit& u, int wid, int lane) const {
        if (wid < 4) __builtin_amdgcn_global_load_lds((const unsigned*)(rowss + u.pm * 256 + wid * 64 + lane), (LAS unsigned*)(tab + wid * 256), 4, 0, 0); }
    __device__ __forceinline__ void fetch_pre(Pre& pre, const LAS unsigned char* tab, int wr, int fr) const {
#pragma unroll
        for (int i = 0; i < 8; ++i) pre.v[i] = ((const LAS unsigned*)tab)[(i >> 2) * 128 + wr * 64 + (i & 3) * 16 + fr]; }
    __device__ __forceinline__ void operator()(const f32x4 (&acc)[2][2][4][2], const Pre& pre, const pg8::Unit& u, int wr, int wc, int fr, int fq) const {
        const int row0 = u.pm * 256 + wr * 64 + fr, h0 = u.pn * 128 + wc * 32 + 8 * fq;
#pragma unroll
        for (int ai = 0; ai < 2; ++ai)
#pragma unroll
            for (int m = 0; m < 4; ++m) {
                const int r = row0 + ai * 128 + m * 16;
                const float rs = __builtin_amdgcn_rsqf((float)pre.v[ai * 4 + m] * (1.0f / (1024.0f * 1024.0f)) + 1e-6f);
                float o[8];
#pragma unroll
                for (int n = 0; n < 2; ++n)
#pragma unroll
                    for (int j = 0; j < 4; ++j) { const float gv = acc[ai][0][m][n][j] * rs, uv = acc[ai][1][m][n][j] * rs; o[n * 4 + j] = gv * uv * fast_sigmoid(gv); }
                u32x4 w; w.x = cvt_pk_bf16(o[0], o[1]); w.y = cvt_pk_bf16(o[2], o[3]); w.z = cvt_pk_bf16(o[4], o[5]); w.w = cvt_pk_bf16(o[6], o[7]);
                *(u32x4*)(O + (size_t)r * DFF + h0) = w;
            }
    }
};
struct EpiProj {
    static constexpr bool PERM = true;
    bf16_t* O; int ldc; const unsigned* rowss;
    struct Pre { unsigned v[8]; };
    static constexpr bool LDS_PRE = true;
    __device__ __forceinline__ void prefetch_lds(LAS unsigned char* tab, const pg8::Unit& u, int wid, int lane) const {
        if (wid < 4) __builtin_amdgcn_global_load_lds((const unsigned*)(rowss + u.pm * 256 + wid * 64 + lane), (LAS unsigned*)(tab + wid * 256), 4, 0, 0); }
    __device__ __forceinline__ void fetch_pre(Pre& pre, const LAS unsigned char* tab, int wr, int fr) const {
#pragma unroll
        for (int i = 0; i < 8; ++i) pre.v[i] = ((const LAS unsigned*)tab)[(i >> 2) * 128 + wr * 64 + (i & 3) * 16 + fr]; }
    __device__ __forceinline__ void operator()(const f32x4 (&acc)[2][2][4][2], const Pre& pre, const pg8::Unit& u, int wr, int wc, int fr, int fq) const {
        const int row0 = u.pm * 256 + wr * 64 + fr, col0 = u.pn * 256 + wc * 32 + 8 * fq;
#pragma unroll
        for (int ai = 0; ai < 2; ++ai)
#pragma unroll
            for (int m = 0; m < 4; ++m) {
                const int r = row0 + ai * 128 + m * 16;
                const float rs = __builtin_amdgcn_rsqf((float)pre.v[ai * 4 + m] * (1.0f / (1024.0f * 1024.0f)) + 1e-6f);
#pragma unroll
                for (int bj = 0; bj < 2; ++bj) {
                    const f32x4 v0 = acc[ai][bj][m][0] * rs, v1 = acc[ai][bj][m][1] * rs;
                    u32x4 w; w.x = cvt_pk_bf16(v0[0], v0[1]); w.y = cvt_pk_bf16(v0[2], v0[3]); w.z = cvt_pk_bf16(v1[0], v1[1]); w.w = cvt_pk_bf16(v1[2], v1[3]);
                    *(u32x4*)(O + (size_t)r * ldc + col0 + bj * 128) = w;
                }
            }
    }
};
template <bool FINAL> struct EpiResid {
    static constexpr bool PERM = true;
    const _Float16* xin; _Float16* xout; float* outf; bf16_t* xb; unsigned* rowss_next; float scale; LAS unsigned char* lds;
    struct Pre { };
    static constexpr bool LDS_PRE = false;
    __device__ __forceinline__ void prefetch_lds(LAS unsigned char*, const pg8::Unit&, int, int) const {}
    __device__ __forceinline__ void fetch_pre(Pre&, const LAS unsigned char*, int, int) const {}
    __device__ __forceinline__ void operator()(const f32x4 (&acc)[2][2][4][2], const Pre&, const pg8::Unit& u, int wr, int wc, int fr, int fq) const {
        const int row0 = u.pm * 256 + wr * 64 + fr, col0 = u.pn * 256 + wc * 32 + 8 * fq;
        f16x8_t xc[2][4][2];
#pragma unroll
        for (int m = 0; m < 4; ++m) { const _Float16* xp = xin + (size_t)(row0 + m * 16) * DM + col0;
#pragma unroll
            for (int bj = 0; bj < 2; ++bj) xc[0][m][bj] = *(const f16x8_t*)(xp + bj * 128); }
#pragma unroll
        for (int m = 0; m < 2; ++m) { const _Float16* xp = xin + (size_t)(row0 + 128 + m * 16) * DM + col0;
#pragma unroll
            for (int bj = 0; bj < 2; ++bj) xc[1][m][bj] = *(const f16x8_t*)(xp + bj * 128); }
        asm volatile("" ::: "memory");
#pragma unroll
        for (int ai = 0; ai < 2; ++ai)
#pragma unroll
            for (int m = 0; m < 4; ++m) {
                if (ai == 0 && m == 1) {
#pragma unroll
                    for (int m2 = 2; m2 < 4; ++m2) { const _Float16* xp = xin + (size_t)(row0 + 128 + m2 * 16) * DM + col0;
#pragma unroll
                        for (int bj = 0; bj < 2; ++bj) xc[1][m2][bj] = *(const f16x8_t*)(xp + bj * 128); }
                }
                const int r = row0 + ai * 128 + m * 16; const size_t off = (size_t)r * DM + col0; float ss = 0.f;
#pragma unroll
                for (int bj = 0; bj < 2; ++bj) {
                    const f16x8_t xv = xc[ai][m][bj];
                    const f32x4 x0 = {(float)xv[0], (float)xv[1], (float)xv[2], (float)xv[3]}, x1 = {(float)xv[4], (float)xv[5], (float)xv[6], (float)xv[7]};
                    const f32x4 o0 = x0 + acc[ai][bj][m][0] * scale, o1 = x1 + acc[ai][bj][m][1] * scale;
                    if (FINAL) { *(f32x4*)(outf + off + bj * 128) = o0; *(f32x4*)(outf + off + bj * 128 + 4) = o1; }
                    else {
                        const f16x4_t h0 = __builtin_convertvector(o0, f16x4_t), h1 = __builtin_convertvector(o1, f16x4_t);
                        const f16x8_t hv = {h0[0], h0[1], h0[2], h0[3], h1[0], h1[1], h1[2], h1[3]};
                        *(f16x8_t*)(xout + off + bj * 128) = hv;
                        ss += (o0[0] * o0[0] + o0[1] * o0[1]) + (o0[2] * o0[2] + o0[3] * o0[3]) + (o1[0] * o1[0] + o1[1] * o1[1]) + (o1[2] * o1[2] + o1[3] * o1[3]);
                    }
                }
                if (!FINAL) { ss += __shfl_xor(ss, 16); ss += __shfl_xor(ss, 32);
                    if (fq == 0) ((LAS float*)(lds + 131072))[((wr * 4 + wc) * 8 + ai * 4 + m) * 16 + fr] = ss; }
            }
        if (!FINAL) {
            asm volatile("s_waitcnt lgkmcnt(0)" ::: "memory"); __builtin_amdgcn_s_barrier(); asm volatile("" ::: "memory");
            if (wc == 0) {
                const int lane = fq * 16 + fr;
#pragma unroll
                for (int hh = 0; hh < 2; ++hh) {
                    const int idx = hh * 64 + lane, g = idx >> 4, f = idx & 15;
                    float t = 0.f;
#pragma unroll
                    for (int w4 = 0; w4 < 4; ++w4) t += ((const LAS float*)(lds + 131072))[((wr * 4 + w4) * 8 + g) * 16 + f];
                    atomicAdd(rowss_next + u.pm * 256 + (g >> 2) * 128 + wr * 64 + (g & 3) * 16 + f, (unsigned)(t * 1024.0f + 0.5f));
                }
            }
        }
    }
};

__device__ __forceinline__ void get_job(const Params& P, int id, const float*& src, bf16_t*& dst, const float*& gain, int& K, int& N, int& mode) {
    unsigned char* ws = P.ws; gain = nullptr; mode = 0;
    if (id < 16) { const int which = id >> 3, ls = id & 7, l = ls >> 1, s = ls & 1;
        src = (which ? P.wu : P.wg) + (size_t)ls * DM * DFF; dst = (bf16_t*)(ws + WS_WGU) + (size_t)ls * 2 * DFF * DM; gain = P.ng + (l * 3 + (s ? 2 : 0)) * DM; K = DM; N = DFF; mode = 1 + which; }
    else if (id < 24) { const int ls = id - 16; src = P.wd + (size_t)ls * DFF * DM; dst = (bf16_t*)(ws + WS_WDN) + (size_t)ls * DFF * DM; K = DFF; N = DM; }
    else if (id < 26) { const int j = id - 24; src = P.abin + (size_t)j * DM * AB_IN; dst = (bf16_t*)(ws + WS_WABIN) + (size_t)j * DM * AB_IN; gain = P.ng + ((2 * j) * 3 + 1) * DM; K = DM; N = AB_IN; }
    else if (id < 28) { const int j = id - 26; src = P.about + (size_t)j * DM * DM; dst = (bf16_t*)(ws + WS_WABOUT) + (size_t)j * DM * DM; K = DM; N = DM; }
    else if (id < 30) { const int j = id - 28; src = P.cin + (size_t)j * DM * HG_IN; dst = (bf16_t*)(ws + WS_WCIN) + (size_t)j * DM * HG_IN; gain = P.ng + ((2 * j + 1) * 3 + 1) * DM; K = DM; N = HG_IN; }
    else if (id < 32) { const int j = id - 30; src = P.cout + (size_t)j * DM * DM; dst = (bf16_t*)(ws + WS_WCOUT) + (size_t)j * DM * DM; K = DM; N = DM; }
    else { const int j = id - 32; src = P.poolw + (size_t)j * 128 * 128; dst = (bf16_t*)(ws + WS_POOLW) + (size_t)j * 128 * 128; K = 128; N = 128; }
}

__device__ void phase0(LAS unsigned char* lds, const Params& P) {
    int tid_ = threadIdx.x; asm volatile("" : "+v"(tid_));
    const int tid = tid_, lane = tid & 63, wave = tid >> 6, G = gridDim.x, bid = blockIdx.x;
    LAS float* tile = (LAS float*)lds;
    for (int id = 0; id < 40; ++id) {
        const float* src; bf16_t* dst; const float* gain; int K, N, mode;
        get_job(P, id, src, dst, gain, K, N, mode);
        const int ntn = N >> 6, ntiles = (K >> 6) * ntn;
        for (int t = bid; t < ntiles; t += G) {
            const int k0 = (t / ntn) << 6, n0 = (t % ntn) << 6;
#pragma unroll
            for (int p = 0; p < 2; ++p) { const int idx = p * 512 + tid, kk = idx >> 4, n4 = (idx & 15) * 4;
                f32x4 v = *(const f32x4*)(src + (size_t)(k0 + kk) * N + n0 + n4); if (gain) v *= gain[k0 + kk];
                tile[kk * 65 + n4] = v[0]; tile[kk * 65 + n4 + 1] = v[1]; tile[kk * 65 + n4 + 2] = v[2]; tile[kk * 65 + n4 + 3] = v[3]; }
            __syncthreads();
#pragma unroll
            for (int p = 0; p < 4; ++p) { const int idx = p * 512 + tid, nn = idx >> 5, kk = (idx & 31) * 2, n = n0 + nn;
                const int drow = mode == 0 ? n : ((n >> 7) * 256 + (n & 127) + (mode == 2 ? 128 : 0));
                const float w0 = tile[kk * 65 + nn], w1 = tile[(kk + 1) * 65 + nn];
                *(unsigned*)(dst + (size_t)drow * K + k0 + kk) = gain ? cvt_pk_f16(w0, w1) : cvt_pk_bf16(w0, w1); }
            __syncthreads();
        }
    }
    bf16_t* xb = (bf16_t*)(P.ws + WS_XB); unsigned* rowss = (unsigned*)(P.ws + WS_ROWSS);
    for (int row0 = (bid * 8 + wave) * 2; row0 < MTOK; row0 += G * 16) {
        f32x4 v[2][4];
#pragma unroll
        for (int rr = 0; rr < 2; ++rr)
#pragma unroll
            for (int i = 0; i < 4; ++i) v[rr][i] = ((const f32x4*)(P.x + (size_t)(row0 + rr) * DM))[lane + 64 * i];
#pragma unroll
        for (int rr = 0; rr < 2; ++rr) { float s = 0.f;
#pragma unroll
            for (int i = 0; i < 4; ++i) { const f32x4 t = v[rr][i]; s += (t[0] * t[0] + t[1] * t[1]) + (t[2] * t[2] + t[3] * t[3]);
                *(f16x4_t*)((_Float16*)P.out + (size_t)(row0 + rr) * DM + 4 * (lane + 64 * i)) = __builtin_convertvector(t, f16x4_t); }
#pragma unroll
            for (int o = 32; o >= 1; o >>= 1) s += __shfl_xor(s, o);
            if (lane == 0) rowss[row0 + rr] = (unsigned)(s * 1024.0f + 0.5f); }
    }
    for (int i = bid * 512 + tid; i < 11 * MTOK; i += G * 512) rowss[MTOK + i] = 0u;
    f32x2* rope = (f32x2*)(P.ws + WS_ROPE);
    for (int i = bid * 512 + tid; i < SEQ * 32; i += G * 512) {
        const int t = i >> 5, fi = i & 31;
        const float inv = exp2f(-(float)fi * (13.287712379549449f / 32.0f));
        const float ang = (float)P.pos[t] * inv;
        const double rev = (double)ang * 0.15915494309189535; const float fr = (float)(rev - floor(rev));
        rope[i] = (f32x2){__builtin_amdgcn_cosf(fr), __builtin_amdgcn_sinf(fr)};
    }
    float* lb = (float*)(P.ws + WS_LB);
    for (int i = bid * 512 + tid; i < 1024; i += G * 512) { const float l0 = P.lbl[i], l1 = P.lbl[1024 + i]; const float mx = fmaxf(l0, l1);
        const float e0 = expf(l0 - mx), e1 = expf(l1 - mx); const float p0 = e0 / (e0 + e1), p1 = e1 / (e0 + e1); lb[i] = p0 - p0; lb[1024 + i] = (p0 + p1) - p0; }
}

constexpr int KS_STRIDE = 72;
constexpr int VT_STRIDE = 264;
constexpr int ATT_KS_OFF = 0, ATT_VT_OFF = 256 * KS_STRIDE * 2;
constexpr int POOL_US_OFF = 0, POOL_DS_OFF = 144 * 128 * 2, POOL_W_OFF = POOL_DS_OFF + 128 * 136 * 2;

__device__ __forceinline__ void rope8r(bf16x8 a, bf16x8 c, float rs, const float* g, const f32x2* ropep, int fi0, bf16x8& r1, bf16x8& r2) {
    float o1[8], o2[8];
#pragma unroll
    for (int e = 0; e < 8; ++e) { const f32x2 cs = ropep[fi0 + e];
        const float y1 = bf2f((unsigned short)a[e]) * rs * g[fi0 + e], y2 = bf2f((unsigned short)c[e]) * rs * g[32 + fi0 + e]; o1[e] = y1 * cs.x - y2 * cs.y; o2[e] = y2 * cs.x + y1 * cs.y; }
    r1 = pack8(o1[0], o1[1], o1[2], o1[3], o1[4], o1[5], o1[6], o1[7]); r2 = pack8(o2[0], o2[1], o2[2], o2[3], o2[4], o2[5], o2[6], o2[7]);
}
__device__ __forceinline__ void rope8(bf16x8 a, bf16x8 c, float rs, const float* g, const f32x2* ropep, int fi0, LAS bf16_t* d1, LAS bf16_t* d2) {
    bf16x8 r1, r2; rope8r(a, c, rs, g, ropep, fi0, r1, r2); *(LAS bf16x8*)d1 = r1; *(LAS bf16x8*)d2 = r2;
}
__device__ void attn_pool_phase(LAS unsigned char* lds, const Params& P, int j, int rev) {
    int tid_ = threadIdx.x; asm volatile("" : "+v"(tid_));
    const int tid = tid_, lane = tid & 63, wave = __builtin_amdgcn_readfirstlane(tid >> 6), li = lane & 15, lh = lane >> 4;
    const bf16_t* proj = (const bf16_t*)(P.ws + WS_ACT);
    bf16_t* cat = (bf16_t*)(P.ws + WS_CAT);
    const f32x2* rope = (const f32x2*)(P.ws + WS_ROPE);
    const float* qg = P.qg + j * 64; const float* kg = P.kg + j * 64;
    LAS bf16_t* Ks = (LAS bf16_t*)(lds + ATT_KS_OFF); LAS bf16_t* Vt = (LAS bf16_t*)(lds + ATT_VT_OFF);
    for (int item0 = blockIdx.x; item0 < 512; item0 += gridDim.x) {
        const int item = rev ? 511 - item0 : item0;
        const int b = item >> 4, blk = item & 15; const int tok0 = b * SEQ + blk * 128;
        for (int kh = 0; kh < 2; ++kh) {
            __syncthreads();
            {
                const int key = tid >> 1, p = tid & 1; const int tpos = blk * 128 - 128 + key;
                LAS bf16_t* krow = Ks + key * KS_STRIDE;
                if (tpos >= 0) {
                    const bf16_t* kp = proj + (size_t)(b * SEQ + tpos) * AB_IN + 512 + 64 * kh;
                    const bf16x8 a0 = *(const bf16x8*)(kp + 16 * p), a1 = *(const bf16x8*)(kp + 16 * p + 8), c0 = *(const bf16x8*)(kp + 32 + 16 * p), c1 = *(const bf16x8*)(kp + 32 + 16 * p + 8);
                    float ss = 0.f;
#pragma unroll
                    for (int e = 0; e < 8; ++e) { const float u0 = bf2f((unsigned short)a0[e]), u1 = bf2f((unsigned short)a1[e]), u2 = bf2f((unsigned short)c0[e]), u3 = bf2f((unsigned short)c1[e]); ss += (u0 * u0 + u1 * u1) + (u2 * u2 + u3 * u3); }
                    ss += __shfl_xor(ss, 1);
                    const float rs = __builtin_amdgcn_rsqf(ss * (1.0f / 64.0f) + 1e-6f);
                    rope8(a0, c0, rs, kg, rope + tpos * 32, 16 * p, krow + 16 * p, krow + 32 + 16 * p);
                    asm volatile("" ::: "memory");
                    rope8(a1, c1, rs, kg, rope + tpos * 32, 16 * p + 8, krow + 16 * p + 8, krow + 32 + 16 * p + 8);
                    asm volatile("" ::: "memory");
                    const bf16_t* vp = proj + (size_t)(b * SEQ + tpos) * AB_IN + 640 + 64 * kh + 32 * p;
#pragma unroll
                    for (int q4 = 0; q4 < 4; ++q4) { const bf16x8 vv = *(const bf16x8*)(vp + 8 * q4);
#pragma unroll
                        for (int e = 0; e < 8; ++e) Vt[(32 * p + 8 * q4 + e) * VT_STRIDE + key] = (bf16_t)vv[e];
                        if (q4 & 1) asm volatile("" ::: "memory"); }
                } else {
                    const bf16x8 z = {0, 0, 0, 0, 0, 0, 0, 0};
                    *(LAS bf16x8*)(krow + 16 * p) = z; *(LAS bf16x8*)(krow + 16 * p + 8) = z; *(LAS bf16x8*)(krow + 32 + 16 * p) = z; *(LAS bf16x8*)(krow + 32 + 16 * p + 8) = z;
#pragma unroll
                    for (int e = 0; e < 32; ++e) Vt[(32 * p + e) * VT_STRIDE + key] = 0;
                }
            }
            const int hq = wave & 1, hd = 4 * kh + (wave >> 1);
            __syncthreads();
            const float sink2 = P.sinks[j * 8 + hd] * 1.4426950408889634f;
            for (int qs = 0; qs < 2; ++qs) {
            const int q0 = 64 * hq + 32 * qs;
            bf16x8 Qf[2][2];
#pragma unroll
            for (int m = 0; m < 2; ++m) {
                const int ql = q0 + 16 * m + li; const int tpos = blk * 128 + ql;
                const bf16_t* qp = proj + (size_t)(tok0 + ql) * AB_IN + 64 * hd + 8 * lh;
                const bf16x8 a = *(const bf16x8*)qp, c = *(const bf16x8*)(qp + 32);
                float ss = 0.f;
#pragma unroll
                for (int e = 0; e < 8; ++e) { const float u0 = bf2f((unsigned short)a[e]), u1 = bf2f((unsigned short)c[e]); ss += u0 * u0 + u1 * u1; }
                ss += __shfl_xor(ss, 16); ss += __shfl_xor(ss, 32);
                const float rs = __builtin_amdgcn_rsqf(ss * (1.0f / 64.0f) + 1e-6f) * (0.125f * 1.4426950408889634f);
                rope8r(a, c, rs, qg, rope + tpos * 32, 8 * lh, Qf[m][0], Qf[m][1]);
                asm volatile("" ::: "memory");
            }
            float mrow[2], lrow[2];
            f32x4 ot[4][2];
#pragma unroll
            for (int m = 0; m < 2; ++m) { mrow[m] = sink2; lrow[m] = 1.0f;
#pragma unroll
                for (int dm = 0; dm < 4; ++dm) ot[dm][m] = (f32x4){0.f, 0.f, 0.f, 0.f}; }
            for (int kt = hq; kt < hq + 3; ++kt) {
                if (blk == 0 && kt < 2) continue;
                f32x4 st[4][2];
#pragma unroll
                for (int n = 0; n < 4; ++n) {
                    const LAS bf16_t* kr = Ks + (64 * kt + 16 * n + li) * KS_STRIDE + 8 * lh;
                    const bf16x8 k0 = *(const LAS bf16x8*)kr, k1 = *(const LAS bf16x8*)(kr + 32);
#pragma unroll
                    for (int m = 0; m < 2; ++m) { f32x4 a = (f32x4){0.f, 0.f, 0.f, 0.f}; a = MFMA16(k0, Qf[m][0], a); a = MFMA16(k1, Qf[m][1], a); st[n][m] = a; }
                }
#pragma unroll
                for (int m = 0; m < 2; ++m) {
                    const int r = q0 + 16 * m + li;
                    float mx = -INFINITY;
#pragma unroll
                    for (int n = 0; n < 4; ++n)
#pragma unroll
                        for (int e = 0; e < 4; ++e) { const int c = 64 * kt + 16 * n + 4 * lh + e; const bool ok = (c > r) && (c <= r + 128);
                            const float s = ok ? st[n][m][e] : -INFINITY; st[n][m][e] = s; mx = fmaxf(mx, s); }
                    mx = fmaxf(mx, __shfl_xor(mx, 16)); mx = fmaxf(mx, __shfl_xor(mx, 32));
                    const float mn = fmaxf(mrow[m], mx); const float alpha = __builtin_amdgcn_exp2f(mrow[m] - mn); mrow[m] = mn;
                    float ls = 0.f;
#pragma unroll
                    for (int n = 0; n < 4; ++n)
#pragma unroll
                        for (int e = 0; e < 4; ++e) { const float pv = __builtin_amdgcn_exp2f(st[n][m][e] - mn); st[n][m][e] = pv; ls += pv; }
                    ls += __shfl_xor(ls, 16); ls += __shfl_xor(ls, 32);
                    lrow[m] = lrow[m] * alpha + ls;
#pragma unroll
                    for (int dm = 0; dm < 4; ++dm) ot[dm][m] *= alpha;
                }
#pragma unroll
                for (int ks = 0; ks < 2; ++ks) {
                    bf16x8 Pf[2];
#pragma unroll
                    for (int m = 0; m < 2; ++m) Pf[m] = pack8(st[2 * ks][m][0], st[2 * ks][m][1], st[2 * ks][m][2], st[2 * ks][m][3], st[2 * ks + 1][m][0], st[2 * ks + 1][m][1], st[2 * ks + 1][m][2], st[2 * ks + 1][m][3]);
#pragma unroll
                    for (int dm = 0; dm < 4; ++dm) {
                        const LAS bf16_t* vr = Vt + (16 * dm + li) * VT_STRIDE + 64 * kt + 32 * ks + 4 * lh;
                        const bf16x4 v0 = *(const LAS bf16x4*)vr, v1 = *(const LAS bf16x4*)(vr + 16);
                        const bf16x8 Vf = {v0[0], v0[1], v0[2], v0[3], v1[0], v1[1], v1[2], v1[3]};
#pragma unroll
                        for (int m = 0; m < 2; ++m) ot[dm][m] = MFMA16(Vf, Pf[m], ot[dm][m]);
                    }
                }
            }
#pragma unroll
            for (int m = 0; m < 2; ++m) {
                const float inv = 1.0f / lrow[m]; const int ql = q0 + 16 * m + li;
                bf16_t* op = cat + (size_t)(tok0 + ql) * DM + 64 * hd + 4 * lh;
#pragma unroll
                for (int dm = 0; dm < 4; ++dm) { const f32x4 o = ot[dm][m] * inv; u32x2 w; w.x = cvt_pk_bf16(o[0], o[1]); w.y = cvt_pk_bf16(o[2], o[3]); *(u32x2*)(op + 16 * dm) = w; }
            }
            }
        }
        LAS bf16_t* Us = (LAS bf16_t*)(lds + POOL_US_OFF); LAS bf16_t* Ds = (LAS bf16_t*)(lds + POOL_DS_OFF); LAS bf16_t* Wp = (LAS bf16_t*)(lds + POOL_W_OFF);
        for (int g = 0; g < 4; ++g) {
            const int w = 2 << g;
            __syncthreads();
            for (int ch = tid; ch < 144 * 16; ch += 512) { const int rr = ch >> 4, c8 = (ch & 15) * 8; const int ts = blk * 128 - 16 + rr;
                bf16x8 v = {0, 0, 0, 0, 0, 0, 0, 0};
                if (ts >= 0) v = *(const bf16x8*)(proj + (size_t)(b * SEQ + ts) * AB_IN + 768 + 128 * g + c8);
                *(LAS bf16x8*)(Us + rr * 128 + c8) = v; }
            { const bf16_t* wsrc = (const bf16_t*)(P.ws + WS_POOLW) + (size_t)(j * 4 + g) * 128 * 128;
              for (int ch = tid; ch < 128 * 16; ch += 512) { const int n = ch >> 4, c8 = (ch & 15) * 8; *(LAS bf16x8*)(Wp + n * 136 + c8) = *(const bf16x8*)(wsrc + n * 128 + c8); } }
            __syncthreads();
            { const int c = tid & 127, tq = tid >> 7; const int t0 = tq * 32;
              float s = 0.f;
              for (int jj = 0; jj < w; ++jj) s += bf2f(Us[(16 + t0 - jj) * 128 + c]);
              for (int t = t0; t < t0 + 32; ++t) {
                  const float ut = bf2f(Us[(16 + t) * 128 + c]);
                  const int cnt = min(blk * 128 + t + 1, w);
                  Ds[t * 136 + c] = f2bf(s / (float)cnt - ut);
                  if (t + 1 < t0 + 32) s += bf2f(Us[(16 + t + 1) * 128 + c]) - bf2f(Us[(16 + t + 1 - w) * 128 + c]);
              } }
            __syncthreads();
            {
                f32x4 pa[8];
#pragma unroll
                for (int nf = 0; nf < 8; ++nf) pa[nf] = (f32x4){0.f, 0.f, 0.f, 0.f};
#pragma unroll
                for (int ks = 0; ks < 4; ++ks) {
                    const bf16x8 df = *(const LAS bf16x8*)(Ds + (16 * wave + li) * 136 + 32 * ks + 8 * lh);
#pragma unroll
                    for (int nf = 0; nf < 8; ++nf) { const bf16x8 wf = *(const LAS bf16x8*)(Wp + (16 * nf + li) * 136 + 32 * ks + 8 * lh); pa[nf] = MFMA16(wf, df, pa[nf]); }
                }
                const float* psc = P.pools + j * 512 + 128 * g;
                bf16_t* op = cat + (size_t)(tok0 + 16 * wave + li) * DM + 512 + 128 * g + 4 * lh;
#pragma unroll
                for (int nf = 0; nf < 8; ++nf) { const f32x4 sc = *(const f32x4*)(psc + 16 * nf + 4 * lh); const f32x4 o = pa[nf] * sc;
                    u32x2 wv; wv.x = cvt_pk_bf16(o[0], o[1]); wv.y = cvt_pk_bf16(o[2], o[3]); *(u32x2*)(op + 16 * nf) = wv; }
            }
        }
    }
    __syncthreads();
}

constexpr int HG_A1 = 0, HG_AP = 8704, HG_BP = 17408, HG_KDT = 26112, HG_VT = 36352, HG_ST = 46592, HG_SC = 81408, HG_TOT = 83968, HG_RED = 86016;

__device__ void hgrn_phase(LAS unsigned char* lds, const Params& P, int j, int rev) {
    int tid_ = threadIdx.x; asm volatile("" : "+v"(tid_));
    const int tid = tid_, lane = tid & 63, wave = __builtin_amdgcn_readfirstlane(tid >> 6), li = lane & 15, lh = lane >> 4;
    const bf16_t* proj = (const bf16_t*)(P.ws + WS_ACT);
    bf16_t* cat = (bf16_t*)(P.ws + WS_CAT);
    LAS bf16_t* A1s = (LAS bf16_t*)(lds + HG_A1); LAS bf16_t* Aps = (LAS bf16_t*)(lds + HG_AP); LAS bf16_t* Bps = (LAS bf16_t*)(lds + HG_BP);
    LAS bf16_t* KdT = (LAS bf16_t*)(lds + HG_KDT); LAS bf16_t* VT = (LAS bf16_t*)(lds + HG_VT); LAS bf16_t* St = (LAS bf16_t*)(lds + HG_ST);
    LAS bf16_t* Sc = (LAS bf16_t*)(lds + HG_SC); LAS float* tot = (LAS float*)(lds + HG_TOT); LAS float* red = (LAS float*)(lds + HG_RED);
    const int kc = tid & 127, tg = tid >> 7;
    for (int item0 = blockIdx.x; item0 < 256; item0 += gridDim.x) {
        const int item = rev ? 255 - item0 : item0;
        const int b = item >> 3, h = item & 7;
        const float lb = ((const float*)(P.ws + WS_LB))[j * 1024 + h * 128 + kc];
        f32x4 og4 = *(const f32x4*)(P.cog + j * 128 + 16 * wave + 4 * lh);
        __syncthreads();
        for (int i = tid; i < 128 * 136 / 2; i += 512) ((LAS unsigned*)St)[i] = 0u;
        f32x4 Sacc[8];
#pragma unroll
        for (int vf = 0; vf < 8; ++vf) Sacc[vf] = (f32x4){0.f, 0.f, 0.f, 0.f};
        unsigned short rq[8], rf[8], ri[8];
        { const bf16_t* p0 = proj + (size_t)(b * SEQ + 8 * tg) * HG_IN + h * 128 + kc;
#pragma unroll
          for (int e = 0; e < 8; ++e) { rq[e] = p0[(size_t)e * HG_IN]; rf[e] = p0[(size_t)e * HG_IN + 1024]; ri[e] = p0[(size_t)e * HG_IN + 2048]; } }
        for (int c = 0; c < 64; ++c) {
            const size_t crow = (size_t)(b * SEQ + 32 * c);
            float cs[8], kk[8], qt[8];
            { float run = 0.f;
#pragma unroll
              for (int e = 0; e < 8; ++e) { const float z = bf2f(rf[e]); const float sg = fast_sigmoid(z); const float f = lb + (1.0f - lb) * sg;
                  run += __logf(fmaxf(f, 1e-6f)); cs[e] = run; kk[e] = 1.0f - f; const float qv = bf2f(rq[e]); qt[e] = qv * fast_sigmoid(qv); }
              tot[tg * 128 + kc] = run; }
            bf16x4 gt[2];
#pragma unroll
            for (int m = 0; m < 2; ++m) gt[m] = *(const bf16x4*)(proj + (crow + 16 * m + li) * HG_IN + 3072 + h * 128 + 16 * wave + 4 * lh);
            __syncthreads();
            { const float t0 = tot[kc], t1 = tot[128 + kc], t2 = tot[256 + kc], t3 = tot[384 + kc];
              const float pre = (tg > 0 ? t0 : 0.f) + (tg > 1 ? t1 : 0.f) + (tg > 2 ? t2 : 0.f);
              const float gm = t0 + t1, gl = gm + t2 + t3;
              float kd[8], vv[8];
#pragma unroll
              for (int e = 0; e < 8; ++e) { const float G = pre + cs[e]; const int t = 8 * tg + e;
                  A1s[t * 136 + kc] = f2bf(qt[e] * fast_exp(G)); Aps[t * 136 + kc] = f2bf(qt[e] * fast_exp(G - gm)); Bps[t * 136 + kc] = f2bf(kk[e] * fast_exp(gm - G));
                  kd[e] = kk[e] * fast_exp(gl - G); vv[e] = bf2f(ri[e]); }
              *(LAS bf16x8*)(KdT + kc * 40 + 8 * tg) = pack8(kd[0], kd[1], kd[2], kd[3], kd[4], kd[5], kd[6], kd[7]);
              *(LAS bf16x8*)(VT + kc * 40 + 8 * tg) = pack8(vv[0], vv[1], vv[2], vv[3], vv[4], vv[5], vv[6], vv[7]); }
            if (c + 1 < 64) { const bf16_t* p0 = proj + (crow + 32 + 8 * tg) * HG_IN + h * 128 + kc;
#pragma unroll
              for (int e = 0; e < 8; ++e) { rq[e] = p0[(size_t)e * HG_IN]; rf[e] = p0[(size_t)e * HG_IN + 1024]; ri[e] = p0[(size_t)e * HG_IN + 2048]; } }
            __syncthreads();
            float dec[4];
#pragma unroll
            for (int e = 0; e < 4; ++e) { const int k = 16 * wave + 4 * lh + e; dec[e] = fast_exp(tot[k] + tot[128 + k] + tot[256 + k] + tot[384 + k]); }
            f32x4 oacc[2] = {(f32x4){0.f, 0.f, 0.f, 0.f}, (f32x4){0.f, 0.f, 0.f, 0.f}};
#pragma unroll
            for (int ks = 0; ks < 4; ++ks) {
                const bf16x8 sf = *(const LAS bf16x8*)(St + (16 * wave + li) * 136 + 32 * ks + 8 * lh);
#pragma unroll
                for (int m = 0; m < 2; ++m) { const bf16x8 af = *(const LAS bf16x8*)(A1s + (16 * m + li) * 136 + 32 * ks + 8 * lh); oacc[m] = MFMA16(sf, af, oacc[m]); }
            }
            if (wave < 3) {
                const int sfr = (wave == 2) ? 1 : 0, tfr = (wave == 0) ? 0 : 1;
                f32x4 sa = (f32x4){0.f, 0.f, 0.f, 0.f};
#pragma unroll
                for (int ks = 0; ks < 4; ++ks) { const bf16x8 bf = *(const LAS bf16x8*)(Bps + (16 * sfr + li) * 136 + 32 * ks + 8 * lh); const bf16x8 af = *(const LAS bf16x8*)(Aps + (16 * tfr + li) * 136 + 32 * ks + 8 * lh); sa = MFMA16(bf, af, sa); }
                const int t = 16 * tfr + li;
                float sv[4];
#pragma unroll
                for (int e = 0; e < 4; ++e) { const int s = 16 * sfr + 4 * lh + e; sv[e] = (s <= t) ? sa[e] : 0.f; }
                u32x2 w; w.x = cvt_pk_bf16(sv[0], sv[1]); w.y = cvt_pk_bf16(sv[2], sv[3]); *(LAS u32x2*)(Sc + t * 40 + 16 * sfr + 4 * lh) = w;
            } else if (wave == 3) { u32x2 w; w.x = 0u; w.y = 0u; *(LAS u32x2*)(Sc + li * 40 + 16 + 4 * lh) = w; }
            __syncthreads();
            { const bf16x8 vf = *(const LAS bf16x8*)(VT + (16 * wave + li) * 40 + 8 * lh);
#pragma unroll
              for (int m = 0; m < 2; ++m) { const bf16x8 sf = *(const LAS bf16x8*)(Sc + (16 * m + li) * 40 + 8 * lh); oacc[m] = MFMA16(vf, sf, oacc[m]); } }
#pragma unroll
            for (int m = 0; m < 2; ++m) { float ss = 0.f;
#pragma unroll
                for (int e = 0; e < 4; ++e) { const float o = oacc[m][e] * fast_sigmoid(bf2f((unsigned short)gt[m][e])); oacc[m][e] = o; ss += o * o; }
                ss += __shfl_xor(ss, 16); ss += __shfl_xor(ss, 32);
                if (lh == 0) red[wave * 32 + 16 * m + li] = ss; }
            __syncthreads();
#pragma unroll
            for (int m = 0; m < 2; ++m) { const int t = 16 * m + li; float ss = 0.f;
#pragma unroll
                for (int w8 = 0; w8 < 8; ++w8) ss += red[w8 * 32 + t];
                const float rs = __builtin_amdgcn_rsqf(ss * (1.0f / 128.0f) + 1e-6f);
                const f32x4 o = oacc[m] * rs * og4; u32x2 w; w.x = cvt_pk_bf16(o[0], o[1]); w.y = cvt_pk_bf16(o[2], o[3]);
                *(u32x2*)(cat + (crow + t) * DM + h * 128 + 16 * wave + 4 * lh) = w; }
            { const bf16x8 kf = *(const LAS bf16x8*)(KdT + (16 * wave + li) * 40 + 8 * lh);
#pragma unroll
              for (int vf = 0; vf < 8; ++vf) { const bf16x8 vfr = *(const LAS bf16x8*)(VT + (16 * vf + li) * 40 + 8 * lh);
                  f32x4 s = Sacc[vf]; s[0] *= dec[0]; s[1] *= dec[1]; s[2] *= dec[2]; s[3] *= dec[3];
                  s = MFMA16(kf, vfr, s); Sacc[vf] = s;
                  u32x2 w; w.x = cvt_pk_bf16(s[0], s[1]); w.y = cvt_pk_bf16(s[2], s[3]); *(LAS u32x2*)(St + (16 * vf + li) * 136 + 16 * wave + 4 * lh) = w; } }
        }
    }
    __syncthreads();
}


__device__ __forceinline__ void grid_barrier(unsigned* bar, unsigned k) {
    asm volatile("s_waitcnt vmcnt(0)" ::: "memory");
    __syncthreads();
    if (threadIdx.x == 0) {
        const unsigned ngrp = 8u, gsz = gridDim.x / ngrp, g = blockIdx.x % ngrp;
        __builtin_amdgcn_fence(__ATOMIC_RELEASE, "agent");
        asm volatile("s_waitcnt vmcnt(0)" ::: "memory");
        const unsigned old = __hip_atomic_fetch_add(bar + 64 * g, 1u, __ATOMIC_RELAXED, __HIP_MEMORY_SCOPE_AGENT);
        if (old + 1u == gsz * k) __hip_atomic_fetch_add(bar + 64 * ngrp, 1u, __ATOMIC_RELAXED, __HIP_MEMORY_SCOPE_AGENT);
        while (__hip_atomic_load(bar + 64 * ngrp, __ATOMIC_RELAXED, __HIP_MEMORY_SCOPE_AGENT) < ngrp * k) __builtin_amdgcn_s_sleep(1);
        __builtin_amdgcn_fence(__ATOMIC_ACQUIRE, "agent");
        asm volatile("s_waitcnt vmcnt(0)" ::: "memory");
    }
    __syncthreads();
}
__global__ void __launch_bounds__(512, 2) mega(Params P) {
    extern __shared__ __attribute__((aligned(16))) unsigned char lds_raw[];
    LAS unsigned char* lds = (LAS unsigned char*)lds_raw;
    cg::grid_group grid = cg::this_grid();
    unsigned char* ws = P.ws;
    bf16_t* xb = (bf16_t*)(ws + WS_XB); bf16_t* act = (bf16_t*)(ws + WS_ACT); bf16_t* cat = (bf16_t*)(ws + WS_CAT); unsigned* rowss = (unsigned*)(ws + WS_ROWSS);
    for (int p = P.lo; p < P.hi; ++p) {
        const bf16_t* xhA = (const bf16_t*)((p > NPHASE_K - 3) ? (ws + WS_ACT + 384 * MiB) : (unsigned char*)P.out);
        if (p > P.lo) { if (P.hi > 1000000) grid.sync(); else grid_barrier((unsigned*)(ws + WS_BAR), (unsigned)(p - P.lo)); }
        if (p == 0) { phase0(lds, P); continue; }
        const int q = p - 1, layer = q / 7, step = q % 7, jj = layer >> 1; const bool even = (layer & 1) == 0;
        pg8::StaticOrder S;
        if (step == 0 || step == 5) {
            const int s = step == 0 ? 0 : 1;
            pg8::Gemm g{xhA, (const bf16_t*)(ws + WS_WGU) + (size_t)(layer * 2 + s) * 2 * DFF * DM, MTOK, 2 * DFF, DM}; S.init(MTOK, 2 * DFF, gridDim.x, blockIdx.x, p & 1);
            EpiSwiglu E{act, rowss + (size_t)(layer * 3 + (s ? 2 : 0)) * MTOK};
            pg8::gemm_phase<EpiSwiglu, true>(lds, g, S, E);
        } else if (step == 2) {
            const int N = even ? AB_IN : HG_IN;
            const bf16_t* W = even ? (const bf16_t*)(ws + WS_WABIN) + (size_t)jj * DM * AB_IN : (const bf16_t*)(ws + WS_WCIN) + (size_t)jj * DM * HG_IN;
            pg8::Gemm g{xhA, W, MTOK, N, DM}; S.init(MTOK, N, gridDim.x, blockIdx.x, p & 1);
            EpiProj E{act, N, rowss + (size_t)(layer * 3 + 1) * MTOK};
            pg8::gemm_phase<EpiProj, true>(lds, g, S, E);
        } else if (step == 3) {
            for (int rep = 0; rep < REP_MIX; ++rep) { if (even) attn_pool_phase(lds, P, jj, p & 1); else hgrn_phase(lds, P, jj, p & 1); }
        } else {
            const bf16_t* A; const bf16_t* W; int K; float scale; int nid;
            if (step == 4) { A = cat; W = even ? (const bf16_t*)(ws + WS_WABOUT) + (size_t)jj * DM * DM : (const bf16_t*)(ws + WS_WCOUT) + (size_t)jj * DM * DM; K = DM; scale = 1.0f; nid = layer * 3 + 2; }
            else { const int s = step == 1 ? 0 : 1; A = act; W = (const bf16_t*)(ws + WS_WDN) + (size_t)(layer * 2 + s) * DFF * DM; K = DFF; scale = 0.5f; nid = s ? (layer + 1) * 3 : layer * 3 + 1; }
            pg8::Gemm g{A, W, MTOK, DM, K}; S.init(MTOK, DM, gridDim.x, blockIdx.x, p & 1);
            _Float16* xh_main = (_Float16*)P.out; _Float16* xh_alt = (_Float16*)(ws + WS_ACT + 384 * MiB);
            if (p == NPHASE_K - 1) { EpiResid<true> E{xh_alt, nullptr, P.out, nullptr, nullptr, scale, lds}; pg8::gemm_phase<EpiResid<true>>(lds, g, S, E); }
            else { EpiResid<false> E{xh_main, (p == NPHASE_K - 3) ? xh_alt : xh_main, nullptr, xb, rowss + (size_t)nid * MTOK, scale, lds}; pg8::gemm_phase<EpiResid<false>>(lds, g, S, E); }
        }
    }
}

constexpr int NPHASE = 29;
#ifndef NRUN
#define NRUN 29
#endif

extern "C" void kernel_launch(void* const* d_in, const int* in_sizes, int n_in, void* d_out, int out_size, void* d_ws, size_t ws_size, hipStream_t stream) {
    static int grid = 0;
    if (grid == 0) {
        if (n_in != 17 || out_size != MTOK * DM || ws_size < WS_END) { fprintf(stderr, "kernel_launch: unexpected shapes (n_in %d out %d ws %zu)\n", n_in, out_size, ws_size); grid = -1; return; }
        int dev = 0, cus = 0, per_cu = 0;
        hipGetDevice(&dev); hipDeviceGetAttribute(&cus, hipDeviceAttributeMultiprocessorCount, dev);
        if (hipFuncSetAttribute((const void*)mega, hipFuncAttributeMaxDynamicSharedMemorySize, LDS_BYTES) != hipSuccess) { fprintf(stderr, "kernel_launch: hipFuncSetAttribute failed\n"); grid = -1; return; }
        if (hipOccupancyMaxActiveBlocksPerMultiprocessor(&per_cu, (const void*)mega, 512, LDS_BYTES) != hipSuccess || per_cu < 1) { fprintf(stderr, "kernel_launch: occupancy query says %d\n", per_cu); per_cu = 1; }
        (void)hipGetLastError();
        grid = cus;
    }
    if (grid < 0) return;
    Params p{};
    p.x = (const float*)d_in[0]; p.pos = (const int*)d_in[1]; p.ng = (const float*)d_in[2]; p.wg = (const float*)d_in[3]; p.wu = (const float*)d_in[4]; p.wd = (const float*)d_in[5];
    p.abin = (const float*)d_in[6]; p.about = (const float*)d_in[7]; p.qg = (const float*)d_in[8]; p.kg = (const float*)d_in[9]; p.sinks = (const float*)d_in[10];
    p.poolw = (const float*)d_in[11]; p.pools = (const float*)d_in[12]; p.cin = (const float*)d_in[13]; p.cout = (const float*)d_in[14]; p.cog = (const float*)d_in[15]; p.lbl = (const float*)d_in[16];
    p.out = (float*)d_out; p.ws = (unsigned char*)d_ws;
#if ONE_LAUNCH
    p.lo = 0; p.hi = NPHASE;
    (void)hipMemsetAsync((unsigned char*)d_ws + WS_BAR, 0, 9 * 256, stream);
    void* args[] = {&p};
    hipError_t e = hipLaunchCooperativeKernel((const void*)mega, dim3(grid), dim3(512), args, LDS_BYTES, stream);
    if (e != hipSuccess) fprintf(stderr, "cooperative launch failed: %s (grid %d)\n", hipGetErrorString(e), grid);
#else
    for (int ph = 0; ph < NRUN; ++ph) { p.lo = ph; p.hi = ph + 1; hipLaunchKernelGGL(mega, dim3(grid), dim3(512), LDS_BYTES, stream, p); }
#endif
}
```

```cpp
#include <hip/hip_runtime.h>
#include <hip/hip_cooperative_groups.h>
#include <cstdio>
namespace cg = cooperative_groups;

#ifndef REP_MIX
#define REP_MIX 1
#endif
#ifndef ONE_LAUNCH
#define ONE_LAUNCH 1
#endif

#define LAS __attribute__((address_space(3)))
typedef unsigned short bf16_t;
typedef short bf16x8 __attribute__((ext_vector_type(8)));
typedef short bf16x4 __attribute__((ext_vector_type(4)));
typedef float f32x4 __attribute__((ext_vector_type(4)));
typedef float f32x2 __attribute__((ext_vector_type(2)));
typedef unsigned u32x4 __attribute__((ext_vector_type(4)));
typedef unsigned u32x2 __attribute__((ext_vector_type(2)));
typedef _Float16 f16x2_t __attribute__((ext_vector_type(2)));
typedef _Float16 f16x4_t __attribute__((ext_vector_type(4)));
typedef _Float16 f16x8_t __attribute__((ext_vector_type(8)));

constexpr int MTOK = 65536, DM = 1024, DFF = 2816, SEQ = 2048, NB = 32;
constexpr int AB_IN = 1280, HG_IN = 4096;
constexpr int LDS_BYTES = 131072 + 4096 + 2048;

constexpr size_t MiB = 1024ull * 1024ull;
constexpr size_t WS_XB = 0;
constexpr size_t WS_ACT = 128 * MiB;
constexpr size_t WS_CAT = 640 * MiB;
constexpr size_t WS_WGU = 768 * MiB;
constexpr size_t WS_WDN = 856 * MiB;
constexpr size_t WS_WABIN = 900 * MiB;
constexpr size_t WS_WABOUT = 905 * MiB;
constexpr size_t WS_WCIN = 909 * MiB;
constexpr size_t WS_WCOUT = 925 * MiB;
constexpr size_t WS_POOLW = 929 * MiB;
constexpr size_t WS_ROWSS = 930 * MiB;
constexpr size_t WS_ROPE = 938 * MiB;
constexpr size_t WS_LB = 939 * MiB;
constexpr size_t WS_BAR = 940 * MiB;
constexpr size_t WS_END = 941 * MiB;

constexpr int NPHASE_K = 29;
struct Params {
    const float* x; const int* pos; const float* ng; const float* wg; const float* wu; const float* wd;
    const float* abin; const float* about; const float* qg; const float* kg; const float* sinks; const float* poolw; const float* pools;
    const float* cin; const float* cout; const float* cog; const float* lbl;
    float* out; unsigned char* ws; int lo, hi;
};

__device__ __forceinline__ float bf2f(unsigned short b) { return __uint_as_float(((unsigned)b) << 16); }
typedef __bf16 bf16x2_t __attribute__((ext_vector_type(2)));
__device__ __forceinline__ unsigned cvt_pk_bf16(float lo, float hi) { f32x2 v = {lo, hi}; bf16x2_t r = __builtin_convertvector(v, bf16x2_t); return __builtin_bit_cast(unsigned, r); }
__device__ __forceinline__ unsigned cvt_pk_f16(float lo, float hi) { f32x2 v = {lo, hi}; f16x2_t r = __builtin_convertvector(v, f16x2_t); return __builtin_bit_cast(unsigned, r); }
__device__ __forceinline__ bf16_t f2bf(float f) { return (bf16_t)(cvt_pk_bf16(f, 0.f) & 0xffffu); }
__device__ __forceinline__ bf16x8 pack8(float a0, float a1, float a2, float a3, float a4, float a5, float a6, float a7) {
    u32x4 w; w.x = cvt_pk_bf16(a0, a1); w.y = cvt_pk_bf16(a2, a3); w.z = cvt_pk_bf16(a4, a5); w.w = cvt_pk_bf16(a6, a7); return __builtin_bit_cast(bf16x8, w); }
__device__ __forceinline__ float fast_exp(float x) { return __builtin_amdgcn_exp2f(x * 1.4426950408889634f); }
__device__ __forceinline__ float fast_sigmoid(float x) { return __builtin_amdgcn_rcpf(1.0f + fast_exp(-x)); }
#define MFMA16(a, b, c) __builtin_amdgcn_mfma_f32_16x16x32_bf16((a), (b), (c), 0, 0, 0)

namespace pg8 {
constexpr int BM = 256, BK = 64, HALF = 128, HTB = HALF * BK * 2, STAGE_BYTES = 8 * HTB, NXCD = 8, WGM = 8;
__device__ __forceinline__ int lds_byte(int r, int c) { const int st = (r >> 4) * 2 + (c >> 5), rr = r & 15, cc = c & 31, ob = rr * 64 + cc * 2; return st * 1024 + (ob ^ (((ob >> 9) & 1) << 5)); }
__device__ __forceinline__ void stage_rc(int b, int& R, int& C) { const int st = b / 1024, sb = b % 1024, swz = sb ^ (((sb >> 9) & 1) << 5); R = (st >> 1) * 16 + swz / 64; C = (st & 1) * 32 + (swz % 64) / 2; }
__device__ __forceinline__ int perm32(int rho) { const int n = rho >> 4, i = rho & 15; return 8 * (i >> 2) + 4 * n + (i & 3); }
struct Unit { int pm, pn; };
struct Gemm { const bf16_t* A; const bf16_t* Bt; int M, N, K; };
struct StaticOrder {
    int nM, nN, nwg, G, c, rev;
    __device__ void init(int M, int N, int G_, int c_, int rev_ = 0) { nM = M / BM; nN = N / BM; nwg = nM * nN; G = G_; c = c_; rev = rev_; }
    __device__ bool next(int i, Unit& u) const {
        long L = (long)i * G + c; if (L >= nwg) return false;
        if (rev) L = nwg - 1 - L;
        int wgid = (int)L; { const int q = nwg / NXCD, r = nwg % NXCD, xcd = wgid % NXCD, off = wgid / NXCD; wgid = (xcd < r ? xcd * (q + 1) : r * (q + 1) + (xcd - r) * q) + off; }
        const int nig = WGM * nN, gid = wgid / nig, fm = gid * WGM, gsz = (nM - fm) < WGM ? (nM - fm) : WGM;
        u.pm = fm + ((wgid % nig) % gsz); u.pn = (wgid % nig) / gsz; return true;
    }
};

template <class Epi, bool F16 = false>
__device__ __forceinline__ void gemm_phase(LAS unsigned char* lds, const Gemm g, const StaticOrder& S, const Epi& E) {
    int tid_ = threadIdx.x; asm volatile("" : "+v"(tid_));
    const int tid = tid_, wid = __builtin_amdgcn_readfirstlane(tid >> 6), lane = tid & 63, wr = wid >> 2, wc = wid & 3, fr = lane & 15, fq = lane >> 4;
    const int K = g.K, nt = K / BK;
    unsigned voffA[2], voffB[2];
#pragma unroll
    for (int i = 0; i < 2; ++i) { int R, C; stage_rc(tid * 16 + i * 8192, R, C); const int Rb = Epi::PERM ? ((R & ~31) + perm32(R & 31)) : R;
        voffA[i] = (unsigned)(R * K + C) * 2u; voffB[i] = (unsigned)(Rb * K + C) * 2u; }
    const long kstep = (long)(BK * 2);
    const size_t hstep = (size_t)HALF * K * 2;
    const size_t tstep = 2 * hstep;
    const unsigned ldsw = (unsigned)wid * 1024u;
    const int aoff = lds_byte(wr * 64 + fr, fq * 8), boff = lds_byte(wc * 32 + fr, fq * 8);
#define PG8_SA(b, h) (((b) * 2 + (h)) * HTB)
#define PG8_SB(b, h) ((4 + (b) * 2 + (h)) * HTB)
#define PG8_STAGE(bufoff, gbase, voff) do { _Pragma("unroll") for (int _i = 0; _i < 2; ++_i) \
        __builtin_amdgcn_global_load_lds((const unsigned*)((const char*)(gbase) + (voff)[_i]), (LAS unsigned*)(lds + (bufoff) + ldsw + _i * 8192), 16, 0, 0); } while (0)
#define PG8_LDA(dst, b, h) do { _Pragma("unroll") for (int m = 0; m < 4; ++m) _Pragma("unroll") for (int k = 0; k < 2; ++k) dst[m][k] = *(const LAS bf16x8*)(lds + PG8_SA(b, h) + aoff + m * 2048 + k * 1024); } while (0)
#define PG8_LDB(dst, b, h) do { _Pragma("unroll") for (int n = 0; n < 2; ++n) _Pragma("unroll") for (int k = 0; k < 2; ++k) dst[n][k] = *(const LAS bf16x8*)(lds + PG8_SB(b, h) + boff + n * 2048 + k * 1024); } while (0)
#define PG8_MMA(ai, bj, At, Bt) do { __builtin_amdgcn_s_setprio(1); _Pragma("unroll") for (int m = 0; m < 4; ++m) _Pragma("unroll") for (int n = 0; n < 2; ++n) _Pragma("unroll") for (int k = 0; k < 2; ++k) \
        acc[ai][bj][m][n] = F16 ? __builtin_amdgcn_mfma_f32_16x16x32_f16(__builtin_bit_cast(f16x8_t, Bt[n][k]), __builtin_bit_cast(f16x8_t, At[m][k]), acc[ai][bj][m][n], 0, 0, 0) \
                                : __builtin_amdgcn_mfma_f32_16x16x32_bf16(Bt[n][k], At[m][k], acc[ai][bj][m][n], 0, 0, 0); __builtin_amdgcn_s_setprio(0); } while (0)
#define PG8_WAIT_V(n) asm volatile("s_waitcnt vmcnt(" #n ")" ::: "memory")
#define PG8_WAIT_L(n) asm volatile("s_waitcnt lgkmcnt(" #n ")" ::: "memory")
#define PG8_BAR __builtin_amdgcn_s_barrier()
#define PG8_SCHED __builtin_amdgcn_sched_barrier(0)
    Unit cur, nxt; int ui = 0;
    if (!S.next(0, cur)) return;
    f32x4 acc[2][2][4][2];
#pragma unroll
    for (int a = 0; a < 2; ++a)
#pragma unroll
        for (int b = 0; b < 2; ++b)
#pragma unroll
            for (int m = 0; m < 4; ++m)
#pragma unroll
                for (int n = 0; n < 2; ++n) acc[a][b][m][n] = (f32x4){0.f, 0.f, 0.f, 0.f};
    bf16x8 At[4][2], B0[2][2], B1[2][2];
    typename Epi::Pre pre; LAS unsigned char* const pretab = lds + 131072 + 4096;
    E.prefetch_lds(pretab, cur, wid, lane);
    const char* cA = (const char*)g.A + (size_t)cur.pm * tstep; const char* cB = (const char*)g.Bt + (size_t)cur.pn * tstep;
    int ck = (int)kstep;
    PG8_STAGE(PG8_SB(0, 0), cB, voffB); PG8_STAGE(PG8_SA(0, 0), cA, voffA); PG8_STAGE(PG8_SB(0, 1), cB + hstep, voffB); PG8_STAGE(PG8_SA(0, 1), cA + hstep, voffA);
    if (wr == 1) PG8_BAR;
    PG8_WAIT_V(4); PG8_BAR;
    PG8_STAGE(PG8_SB(1, 0), cB + kstep, voffB); PG8_STAGE(PG8_SA(1, 0), cA + kstep, voffA); PG8_STAGE(PG8_SB(1, 1), cB + hstep + kstep, voffB);
    PG8_WAIT_V(6); PG8_BAR;
    for (;;) {
        const bool has_next = S.next(ui + 1, nxt);
        const int nk = has_next ? -ck : ck; const int nofs = (has_next && nk < 0) ? (nt - 1) * (int)kstep : 0;
        const char* nA = has_next ? (const char*)g.A + (size_t)nxt.pm * tstep + nofs : cA; const char* nB = has_next ? (const char*)g.Bt + (size_t)nxt.pn * tstep + nofs : cB;
        for (int t = 0; t < nt; t += 2) {
            const bool last = (t == nt - 2);
            const char* a1 = cA + (t + 1) * ck;
            const char* a2 = last ? nA : cA + (t + 2) * ck; const char* b2 = last ? nB : cB + (t + 2) * ck;
            const int k3 = last ? nk : ck; const char* a3 = a2 + k3; const char* b3 = b2 + k3;
            PG8_LDB(B0, 0, 0); PG8_SCHED; PG8_LDA(At, 0, 0); PG8_STAGE(PG8_SA(1, 1), a1 + hstep, voffA);
            PG8_WAIT_L(8); PG8_BAR; PG8_WAIT_L(0); PG8_MMA(0, 0, At, B0); PG8_BAR; PG8_SCHED;
            PG8_LDB(B1, 0, 1); PG8_STAGE(PG8_SB(0, 0), b2, voffB);
            PG8_BAR; PG8_WAIT_L(0); PG8_MMA(0, 1, At, B1); PG8_BAR;
            PG8_LDA(At, 0, 1); PG8_STAGE(PG8_SA(0, 0), a2, voffA);
            PG8_BAR; PG8_WAIT_L(0); PG8_MMA(1, 0, At, B0); PG8_BAR; PG8_SCHED;
            PG8_STAGE(PG8_SB(0, 1), b2 + hstep, voffB);
            PG8_WAIT_V(6); PG8_BAR; PG8_MMA(1, 1, At, B1); PG8_BAR;
            PG8_LDB(B0, 1, 0); PG8_SCHED; PG8_LDA(At, 1, 0); PG8_STAGE(PG8_SA(0, 1), a2 + hstep, voffA);
            PG8_WAIT_L(8); PG8_BAR; PG8_WAIT_L(0); PG8_MMA(0, 0, At, B0); PG8_BAR; PG8_SCHED;
            PG8_LDB(B1, 1, 1); PG8_STAGE(PG8_SB(1, 0), b3, voffB);
            PG8_BAR; PG8_WAIT_L(0); PG8_MMA(0, 1, At, B1); PG8_BAR;
            PG8_LDA(At, 1, 1); PG8_STAGE(PG8_SA(1, 0), a3, voffA);
            PG8_BAR; PG8_WAIT_L(0); PG8_MMA(1, 0, At, B0); PG8_BAR; PG8_SCHED;
            PG8_STAGE(PG8_SB(1, 1), b3 + hstep, voffB);
            PG8_WAIT_V(6); PG8_BAR; PG8_MMA(1, 1, At, B1); PG8_BAR;
        }
        E.fetch_pre(pre, pretab + (ui & 1) * 1024, wr, fr);
        E(acc, pre, cur, wr, wc, fr, fq);
        if (!has_next) break;
        E.prefetch_lds(pretab + ((ui + 1) & 1) * 1024, nxt, wid, lane);
#pragma unroll
        for (int a = 0; a < 2; ++a)
#pragma unroll
            for (int b = 0; b < 2; ++b)
#pragma unroll
                for (int m = 0; m < 4; ++m)
#pragma unroll
                    for (int n = 0; n < 2; ++n) acc[a][b][m][n] = (f32x4){0.f, 0.f, 0.f, 0.f};
        cur = nxt; cA = nA; cB = nB; ck = nk; ++ui;
    }
    PG8_WAIT_V(0);
    if (wr == 0) PG8_BAR;
    PG8_BAR;
#undef PG8_SA
#undef PG8_SB
#undef PG8_STAGE
#undef PG8_LDA
#undef PG8_LDB
#undef PG8_MMA
#undef PG8_WAIT_V
#undef PG8_WAIT_L
#undef PG8_BAR
#undef PG8_SCHED
}
}

struct EpiSwiglu {
    static constexpr bool PERM = true;
    bf16_t* O; const unsigned* rowss;
    struct Pre { unsigned v[8]; };
    static constexpr bool LDS_PRE = true;
    __device__ __forceinline__ void prefetch_lds(LAS unsigned char* tab, const pg8::Unit& u, int wid, int lane) const {
        if (wid < 4) __builtin_amdgcn_global_load_lds((const unsigned*)(rowss + u.pm * 256 + wid * 64 + lane), (LAS unsigned*)(tab + wid * 256), 4, 0, 0); }
    __device__ __forceinline__ void fetch_pre(Pre& pre, const LAS unsigned char* tab, int wr, int fr) const {
#pragma unroll
        for (int i = 0; i < 8; ++i) pre.v[i] = ((const LAS unsigned*)tab)[(i >> 2) * 128 + wr * 64 + (i & 3) * 16 + fr]; }
    __device__ __forceinline__ void operator()(const f32x4 (&acc)[2][2][4][2], const Pre& pre, const pg8::Unit& u, int wr, int wc, int fr, int fq) const {
        const int row0 = u.pm * 256 + wr * 64 + fr, h0 = u.pn * 128 + wc * 32 + 8 * fq;
#pragma unroll
        for (int ai = 0; ai < 2; ++ai)
#pragma unroll
            for (int m = 0; m < 4; ++m) {
                const int r = row0 + ai * 128 + m * 16;
                const float rs = __builtin_amdgcn_rsqf((float)pre.v[ai * 4 + m] * (1.0f / (1024.0f * 1024.0f)) + 1e-6f);
                float o[8];
#pragma unroll
                for (int n = 0; n < 2; ++n)
#pragma unroll
                    for (int j = 0; j < 4; ++j) { const float gv = acc[ai][0][m][n][j] * rs, uv = acc[ai][1][m][n][j] * rs; o[n * 4 + j] = gv * uv * fast_sigmoid(gv); }
                u32x4 w; w.x = cvt_pk_bf16(o[0], o[1]); w.y = cvt_pk_bf16(o[2], o[3]); w.z = cvt_pk_bf16(o[4], o[5]); w.w = cvt_pk_bf16(o[6], o[7]);
                *(u32x4*)(O + (size_t)r * DFF + h0) = w;
            }
    }
};
struct EpiProj {
    static constexpr bool PERM = true;
    bf16_t* O; int ldc; const unsigned* rowss;
    struct Pre { unsigned v[8]; };
    static constexpr bool LDS_PRE = true;
    __device__ __forceinline__ void prefetch_lds(LAS unsigned char* tab, const pg8::Unit& u, int wid, int lane) const {
        if (wid < 4) __builtin_amdgcn_global_load_lds((const unsigned*)(rowss + u.pm * 256 + wid * 64 + lane), (LAS unsigned*)(tab + wid * 256), 4, 0, 0); }
    __device__ __forceinline__ void fetch_pre(Pre& pre, const LAS unsigned char* tab, int wr, int fr) const {
#pragma unroll
        for (int i = 0; i < 8; ++i) pre.v[i] = ((const LAS unsigned*)tab)[(i >> 2) * 128 + wr * 64 + (i & 3) * 16 + fr]; }
    __device__ __forceinline__ void operator()(const f32x4 (&acc)[2][2][4][2], const Pre& pre, const pg8::Unit& u, int wr, int wc, int fr, int fq) const {
        const int row0 = u.pm * 256 + wr * 64 + fr, col0 = u.pn * 256 + wc * 32 + 8 * fq;
#pragma unroll
        for (int ai = 0; ai < 2; ++ai)
#pragma unroll
            for (int m = 0; m < 4; ++m) {
                const int r = row0 + ai * 128 + m * 16;
                const float rs = __builtin_amdgcn_rsqf((float)pre.v[ai * 4 + m] * (1.0f / (1024.0f * 1024.0f)) + 1e-6f);
#pragma unroll
                for (int bj = 0; bj < 2; ++bj) {
                    const f32x4 v0 = acc[ai][bj][m][0] * rs, v1 = acc[ai][bj][m][1] * rs;
                    u32x4 w; w.x = cvt_pk_bf16(v0[0], v0[1]); w.y = cvt_pk_bf16(v0[2], v0[3]); w.z = cvt_pk_bf16(v1[0], v1[1]); w.w = cvt_pk_bf16(v1[2], v1[3]);
                    *(u32x4*)(O + (size_t)r * ldc + col0 + bj * 128) = w;
                }
            }
    }
};
template <bool FINAL> struct EpiResid {
    static constexpr bool PERM = true;
    const _Float16* xin; _Float16* xout; float* outf; bf16_t* xb; unsigned* rowss_next; float scale; LAS unsigned char* lds;
    struct Pre { };
    static constexpr bool LDS_PRE = false;
    __device__ __forceinline__ void prefetch_lds(LAS unsigned char*, const pg8::Unit&, int, int) const {}
    __device__ __forceinline__ void fetch_pre(Pre&, const LAS unsigned char*, int, int) const {}
    __device__ __forceinline__ void operator()(const f32x4 (&acc)[2][2][4][2], const Pre&, const pg8::Unit& u, int wr, int wc, int fr, int fq) const {
        const int row0 = u.pm * 256 + wr * 64 + fr, col0 = u.pn * 256 + wc * 32 + 8 * fq;
        f16x8_t xc[2][4][2];
#pragma unroll
        for (int m = 0; m < 4; ++m) { const _Float16* xp = xin + (size_t)(row0 + m * 16) * DM + col0;
#pragma unroll
            for (int bj = 0; bj < 2; ++bj) xc[0][m][bj] = *(const f16x8_t*)(xp + bj * 128); }
#pragma unroll
        for (int m = 0; m < 2; ++m) { const _Float16* xp = xin + (size_t)(row0 + 128 + m * 16) * DM + col0;
#pragma unroll
            for (int bj = 0; bj < 2; ++bj) xc[1][m][bj] = *(const f16x8_t*)(xp + bj * 128); }
        asm volatile("" ::: "memory");
#pragma unroll
        for (int ai = 0; ai < 2; ++ai)
#pragma unroll
            for (int m = 0; m < 4; ++m) {
                if (ai == 0 && m == 1) {
#pragma unroll
                    for (int m2 = 2; m2 < 4; ++m2) { const _Float16* xp = xin + (size_t)(row0 + 128 + m2 * 16) * DM + col0;
#pragma unroll
                        for (int bj = 0; bj < 2; ++bj) xc[1][m2][bj] = *(const f16x8_t*)(xp + bj * 128); }
                }
                const int r = row0 + ai * 128 + m * 16; const size_t off = (size_t)r * DM + col0; float ss = 0.f;
#pragma unroll
                for (int bj = 0; bj < 2; ++bj) {
                    const f16x8_t xv = xc[ai][m][bj];
                    const f32x4 x0 = {(float)xv[0], (float)xv[1], (float)xv[2], (float)xv[3]}, x1 = {(float)xv[4], (float)xv[5], (float)xv[6], (float)xv[7]};
                    const f32x4 o0 = x0 + acc[ai][bj][m][0] * scale, o1 = x1 + acc[ai][bj][m][1] * scale;
                    if (FINAL) { *(f32x4*)(outf + off + bj * 128) = o0; *(f32x4*)(outf + off + bj * 128 + 4) = o1; }
                    else {
                        const f16x4_t h0 = __builtin_convertvector(o0, f16x4_t), h1 = __builtin_convertvector(o1, f16x4_t);
                        const f16x8_t hv = {h0[0], h0[1], h0[2], h0[3], h1[0], h1[1], h1[2], h1[3]};
                        *(f16x8_t*)(xout + off + bj * 128) = hv;
                        ss += (o0[0] * o0[0] + o0[1] * o0[1]) + (o0[2] * o0[2] + o0[3] * o0[3]) + (o1[0] * o1[0] + o1[1] * o1[1]) + (o1[2] * o1[2] + o1[3] * o1[3]);
                    }
                }
                if (!FINAL) { ss += __shfl_xor(ss, 16); ss += __shfl_xor(ss, 32);
                    if (fq == 0) ((LAS float*)(lds + 131072))[((wr * 4 + wc) * 8 + ai * 4 + m) * 16 + fr] = ss; }
            }
        if (!FINAL) {
            asm volatile("s_waitcnt lgkmcnt(0)" ::: "memory"); __builtin_amdgcn_s_barrier(); asm volatile("" ::: "memory");
            if (wc == 0) {
                const int lane = fq * 16 + fr;
#pragma unroll
                for (int hh = 0; hh < 2; ++hh) {
                    const int idx = hh * 64 + lane, g = idx >> 4, f = idx & 15;
                    float t = 0.f;
#pragma unroll
                    for (int w4 = 0; w4 < 4; ++w4) t += ((const LAS float*)(lds + 131072))[((wr * 4 + w4) * 8 + g) * 16 + f];
                    atomicAdd(rowss_next + u.pm * 256 + (g >> 2) * 128 + wr * 64 + (g & 3) * 16 + f, (unsigned)(t * 1024.0f + 0.5f));
                }
            }
        }
    }
};

__device__ __forceinline__ void get_job(const Params& P, int id, const float*& src, bf16_t*& dst, const float*& gain, int& K, int& N, int& mode) {
    unsigned char* ws = P.ws; gain = nullptr; mode = 0;
    if (id < 16) { const int which = id >> 3, ls = id & 7, l = ls >> 1, s = ls & 1;
        src = (which ? P.wu : P.wg) + (size_t)ls * DM * DFF; dst = (bf16_t*)(ws + WS_WGU) + (size_t)ls * 2 * DFF * DM; gain = P.ng + (l * 3 + (s ? 2 : 0)) * DM; K = DM; N = DFF; mode = 1 + which; }
    else if (id < 24) { const int ls = id - 16; src = P.wd + (size_t)ls * DFF * DM; dst = (bf16_t*)(ws + WS_WDN) + (size_t)ls * DFF * DM; K = DFF; N = DM; }
    else if (id < 26) { const int j = id - 24; src = P.abin + (size_t)j * DM * AB_IN; dst = (bf16_t*)(ws + WS_WABIN) + (size_t)j * DM * AB_IN; gain = P.ng + ((2 * j) * 3 + 1) * DM; K = DM; N = AB_IN; }
    else if (id < 28) { const int j = id - 26; src = P.about + (size_t)j * DM * DM; dst = (bf16_t*)(ws + WS_WABOUT) + (size_t)j * DM * DM; K = DM; N = DM; }
    else if (id < 30) { const int j = id - 28; src = P.cin + (size_t)j * DM * HG_IN; dst = (bf16_t*)(ws + WS_WCIN) + (size_t)j * DM * HG_IN; gain = P.ng + ((2 * j + 1) * 3 + 1) * DM; K = DM; N = HG_IN; }
    else if (id < 32) { const int j = id - 30; src = P.cout + (size_t)j * DM * DM; dst = (bf16_t*)(ws + WS_WCOUT) + (size_t)j * DM * DM; K = DM; N = DM; }
    else { const int j = id - 32; src = P.poolw + (size_t)j * 128 * 128; dst = (bf16_t*)(ws + WS_POOLW) + (size_t)j * 128 * 128; K = 128; N = 128; }
}

__device__ void phase0(LAS unsigned char* lds, const Params& P) {
    int tid_ = threadIdx.x; asm volatile("" : "+v"(tid_));
    const int tid = tid_, lane = tid & 63, wave = tid >> 6, G = gridDim.x, bid = blockIdx.x;
    LAS float* tile = (LAS float*)lds;
    for (int id = 0; id < 40; ++id) {
        const float* src; bf16_t* dst; const float* gain; int K, N, mode;
        get_job(P, id, src, dst, gain, K, N, mode);
        const int ntn = N >> 6, ntiles = (K >> 6) * ntn;
        for (int t = bid; t < ntiles; t += G) {
            const int k0 = (t / ntn) << 6, n0 = (t % ntn) << 6;
#pragma unroll
            for (int p = 0; p < 2; ++p) { const int idx = p * 512 + tid, kk = idx >> 4, n4 = (idx & 15) * 4;
                f32x4 v = *(const f32x4*)(src + (size_t)(k0 + kk) * N + n0 + n4); if (gain) v *= gain[k0 + kk];
                tile[kk * 65 + n4] = v[0]; tile[kk * 65 + n4 + 1] = v[1]; tile[kk * 65 + n4 + 2] = v[2]; tile[kk * 65 + n4 + 3] = v[3]; }
            __syncthreads();
#pragma unroll
            for (int p = 0; p < 4; ++p) { const int idx = p * 512 + tid, nn = idx >> 5, kk = (idx & 31) * 2, n = n0 + nn;
                const int drow = mode == 0 ? n : ((n >> 7) * 256 + (n & 127) + (mode == 2 ? 128 : 0));
                const float w0 = tile[kk * 65 + nn], w1 = tile[(kk + 1) * 65 + nn];
                *(unsigned*)(dst + (size_t)drow * K + k0 + kk) = gain ? cvt_pk_f16(w0, w1) : cvt_pk_bf16(w0, w1); }
            __syncthreads();
        }
    }
    bf16_t* xb = (bf16_t*)(P.ws + WS_XB); unsigned* rowss = (unsigned*)(P.ws + WS_ROWSS);
    for (int row0 = (bid * 8 + wave) * 2; row0 < MTOK; row0 += G * 16) {
        f32x4 v[2][4];
#pragma unroll
        for (int rr = 0; rr < 2; ++rr)
#pragma unroll
            for (int i = 0; i < 4; ++i) v[rr][i] = ((const f32x4*)(P.x + (size_t)(row0 + rr) * DM))[lane + 64 * i];
#pragma unroll
        for (int rr = 0; rr < 2; ++rr) { float s = 0.f;
#pragma unroll
            for (int i = 0; i < 4; ++i) { const f32x4 t = v[rr][i]; s += (t[0] * t[0] + t[1] * t[1]) + (t[2] * t[2] + t[3] * t[3]);
                *(f16x4_t*)((_Float16*)P.out + (size_t)(row0 + rr) * DM + 4 * (lane + 64 * i)) = __builtin_convertvector(t, f16x4_t); }
#pragma unroll
            for (int o = 32; o >= 1; o >>= 1) s += __shfl_xor(s, o);
            if (lane == 0) rowss[row0 + rr] = (unsigned)(s * 1024.0f + 0.5f); }
    }
    const int gtid = bid * 512 + tid, gthr = G * 512;
#pragma unroll 1
    for (int base = 0; base < 11 * MTOK; base += gthr) { const int i = base + gtid; if (i < 11 * MTOK) rowss[MTOK + i] = 0u; }
    f32x2* rope = (f32x2*)(P.ws + WS_ROPE);
#pragma unroll 1
    for (int base = 0; base < SEQ * 32; base += gthr) { const int i = base + gtid; if (i >= SEQ * 32) break;
        const int t = i >> 5, fi = i & 31;
        const float inv = exp2f(-(float)fi * (13.287712379549449f / 32.0f));
        const float ang = (float)P.pos[t] * inv;
        const double rev = (double)ang * 0.15915494309189535; const float fr = (float)(rev - floor(rev));
        rope[i] = (f32x2){__builtin_amdgcn_cosf(fr), __builtin_amdgcn_sinf(fr)};
    }
    float* lb = (float*)(P.ws + WS_LB);
#pragma unroll 1
    for (int base = 0; base < 1024; base += gthr) { const int i = base + gtid; if (i >= 1024) break; const float l0 = P.lbl[i], l1 = P.lbl[1024 + i]; const float mx = fmaxf(l0, l1);
        const float e0 = expf(l0 - mx), e1 = expf(l1 - mx); const float p0 = e0 / (e0 + e1), p1 = e1 / (e0 + e1); lb[i] = p0 - p0; lb[1024 + i] = (p0 + p1) - p0; }
}

constexpr int KS_STRIDE = 72;
constexpr int VT_STRIDE = 264;
constexpr int ATT_KS_OFF = 0, ATT_VT_OFF = 256 * KS_STRIDE * 2;
constexpr int POOL_US_OFF = 0, POOL_DS_OFF = 144 * 128 * 2, POOL_W_OFF = POOL_DS_OFF + 128 * 136 * 2;

__device__ __forceinline__ void rope8r(bf16x8 a, bf16x8 c, float rs, const float* g, const f32x2* ropep, int fi0, bf16x8& r1, bf16x8& r2) {
    float o1[8], o2[8];
#pragma unroll
    for (int e = 0; e < 8; ++e) { const f32x2 cs = ropep[fi0 + e];
        const float y1 = bf2f((unsigned short)a[e]) * rs * g[fi0 + e], y2 = bf2f((unsigned short)c[e]) * rs * g[32 + fi0 + e]; o1[e] = y1 * cs.x - y2 * cs.y; o2[e] = y2 * cs.x + y1 * cs.y; }
    r1 = pack8(o1[0], o1[1], o1[2], o1[3], o1[4], o1[5], o1[6], o1[7]); r2 = pack8(o2[0], o2[1], o2[2], o2[3], o2[4], o2[5], o2[6], o2[7]);
}
__device__ __forceinline__ void rope8(bf16x8 a, bf16x8 c, float rs, const float* g, const f32x2* ropep, int fi0, LAS bf16_t* d1, LAS bf16_t* d2) {
    bf16x8 r1, r2; rope8r(a, c, rs, g, ropep, fi0, r1, r2); *(LAS bf16x8*)d1 = r1; *(LAS bf16x8*)d2 = r2;
}
__device__ void attn_pool_phase(LAS unsigned char* lds, const Params& P, int j, int rev) {
    int tid_ = threadIdx.x; asm volatile("" : "+v"(tid_));
    const int tid = tid_, lane = tid & 63, wave = __builtin_amdgcn_readfirstlane(tid >> 6), li = lane & 15, lh = lane >> 4;
    const bf16_t* proj = (const bf16_t*)(P.ws + WS_ACT);
    bf16_t* cat = (bf16_t*)(P.ws + WS_CAT);
    const f32x2* rope = (const f32x2*)(P.ws + WS_ROPE);
    const float* qg = P.qg + j * 64; const float* kg = P.kg + j * 64;
    LAS bf16_t* Ks = (LAS bf16_t*)(lds + ATT_KS_OFF); LAS bf16_t* Vt = (LAS bf16_t*)(lds + ATT_VT_OFF);
    for (int item0 = blockIdx.x; item0 < 512; item0 += gridDim.x) {
        const int item = rev ? 511 - item0 : item0;
        const int b = item >> 4, blk = item & 15; const int tok0 = b * SEQ + blk * 128;
        for (int kh = 0; kh < 2; ++kh) {
            __syncthreads();
            {
                const int key = tid >> 1, p = tid & 1; const int tpos = blk * 128 - 128 + key;
                LAS bf16_t* krow = Ks + key * KS_STRIDE;
                if (tpos >= 0) {
                    const bf16_t* kp = proj + (size_t)(b * SEQ + tpos) * AB_IN + 512 + 64 * kh;
                    const bf16x8 a0 = *(const bf16x8*)(kp + 16 * p), a1 = *(const bf16x8*)(kp + 16 * p + 8), c0 = *(const bf16x8*)(kp + 32 + 16 * p), c1 = *(const bf16x8*)(kp + 32 + 16 * p + 8);
                    float ss = 0.f;
#pragma unroll
                    for (int e = 0; e < 8; ++e) { const float u0 = bf2f((unsigned short)a0[e]), u1 = bf2f((unsigned short)a1[e]), u2 = bf2f((unsigned short)c0[e]), u3 = bf2f((unsigned short)c1[e]); ss += (u0 * u0 + u1 * u1) + (u2 * u2 + u3 * u3); }
                    ss += __shfl_xor(ss, 1);
                    const float rs = __builtin_amdgcn_rsqf(ss * (1.0f / 64.0f) + 1e-6f);
                    rope8(a0, c0, rs, kg, rope + tpos * 32, 16 * p, krow + 16 * p, krow + 32 + 16 * p);
                    asm volatile("" ::: "memory");
                    rope8(a1, c1, rs, kg, rope + tpos * 32, 16 * p + 8, krow + 16 * p + 8, krow + 32 + 16 * p + 8);
                    asm volatile("" ::: "memory");
                    const bf16_t* vp = proj + (size_t)(b * SEQ + tpos) * AB_IN + 640 + 64 * kh + 32 * p;
#pragma unroll
                    for (int q4 = 0; q4 < 4; ++q4) { const bf16x8 vv = *(const bf16x8*)(vp + 8 * q4);
#pragma unroll
                        for (int e = 0; e < 8; ++e) Vt[(32 * p + 8 * q4 + e) * VT_STRIDE + key] = (bf16_t)vv[e];
                        if (q4 & 1) asm volatile("" ::: "memory"); }
                } else {
                    const bf16x8 z = {0, 0, 0, 0, 0, 0, 0, 0};
                    *(LAS bf16x8*)(krow + 16 * p) = z; *(LAS bf16x8*)(krow + 16 * p + 8) = z; *(LAS bf16x8*)(krow + 32 + 16 * p) = z; *(LAS bf16x8*)(krow + 32 + 16 * p + 8) = z;
#pragma unroll
                    for (int e = 0; e < 32; ++e) Vt[(32 * p + e) * VT_STRIDE + key] = 0;
                }
            }
            const int hq = wave & 1, hd = 4 * kh + (wave >> 1);
            __syncthreads();
            const float sink2 = P.sinks[j * 8 + hd] * 1.4426950408889634f;
            for (int qs = 0; qs < 2; ++qs) {
            const int q0 = 64 * hq + 32 * qs;
            bf16x8 Qf[2][2];
#pragma unroll
            for (int m = 0; m < 2; ++m) {
                const int ql = q0 + 16 * m + li; const int tpos = blk * 128 + ql;
                const bf16_t* qp = proj + (size_t)(tok0 + ql) * AB_IN + 64 * hd + 8 * lh;
                const bf16x8 a = *(const bf16x8*)qp, c = *(const bf16x8*)(qp + 32);
                float ss = 0.f;
#pragma unroll
                for (int e = 0; e < 8; ++e) { const float u0 = bf2f((unsigned short)a[e]), u1 = bf2f((unsigned short)c[e]); ss += u0 * u0 + u1 * u1; }
                ss += __shfl_xor(ss, 16); ss += __shfl_xor(ss, 32);
                const float rs = __builtin_amdgcn_rsqf(ss * (1.0f / 64.0f) + 1e-6f) * (0.125f * 1.4426950408889634f);
                rope8r(a, c, rs, qg, rope + tpos * 32, 8 * lh, Qf[m][0], Qf[m][1]);
                asm volatile("" ::: "memory");
            }
            float mrow[2], lrow[2];
            f32x4 ot[4][2];
#pragma unroll
            for (int m = 0; m < 2; ++m) { mrow[m] = sink2; lrow[m] = 1.0f;
#pragma unroll
                for (int dm = 0; dm < 4; ++dm) ot[dm][m] = (f32x4){0.f, 0.f, 0.f, 0.f}; }
            for (int kt = hq; kt < hq + 3; ++kt) {
                if (blk == 0 && kt < 2) continue;
                f32x4 st[4][2];
#pragma unroll
                for (int n = 0; n < 4; ++n) {
                    const LAS bf16_t* kr = Ks + (64 * kt + 16 * n + li) * KS_STRIDE + 8 * lh;
                    const bf16x8 k0 = *(const LAS bf16x8*)kr, k1 = *(const LAS bf16x8*)(kr + 32);
#pragma unroll
                    for (int m = 0; m < 2; ++m) { f32x4 a = (f32x4){0.f, 0.f, 0.f, 0.f}; a = MFMA16(k0, Qf[m][0], a); a = MFMA16(k1, Qf[m][1], a); st[n][m] = a; }
                }
#pragma unroll
                for (int m = 0; m < 2; ++m) {
                    const int r = q0 + 16 * m + li;
                    float mx = -INFINITY;
#pragma unroll
                    for (int n = 0; n < 4; ++n)
#pragma unroll
                        for (int e = 0; e < 4; ++e) { const int c = 64 * kt + 16 * n + 4 * lh + e; const bool ok = (c > r) && (c <= r + 128);
                            const float s = ok ? st[n][m][e] : -INFINITY; st[n][m][e] = s; mx = fmaxf(mx, s); }
                    mx = fmaxf(mx, __shfl_xor(mx, 16)); mx = fmaxf(mx, __shfl_xor(mx, 32));
                    const float mn = fmaxf(mrow[m], mx); const float alpha = __builtin_amdgcn_exp2f(mrow[m] - mn); mrow[m] = mn;
                    float ls = 0.f;
#pragma unroll
                    for (int n = 0; n < 4; ++n)
#pragma unroll
                        for (int e = 0; e < 4; ++e) { const float pv = __builtin_amdgcn_exp2f(st[n][m][e] - mn); st[n][m][e] = pv; ls += pv; }
                    ls += __shfl_xor(ls, 16); ls += __shfl_xor(ls, 32);
                    lrow[m] = lrow[m] * alpha + ls;
#pragma unroll
                    for (int dm = 0; dm < 4; ++dm) ot[dm][m] *= alpha;
                }
#pragma unroll
                for (int ks = 0; ks < 2; ++ks) {
                    bf16x8 Pf[2];
#pragma unroll
                    for (int m = 0; m < 2; ++m) Pf[m] = pack8(st[2 * ks][m][0], st[2 * ks][m][1], st[2 * ks][m][2], st[2 * ks][m][3], st[2 * ks + 1][m][0], st[2 * ks + 1][m][1], st[2 * ks + 1][m][2], st[2 * ks + 1][m][3]);
#pragma unroll
                    for (int dm = 0; dm < 4; ++dm) {
                        const LAS bf16_t* vr = Vt + (16 * dm + li) * VT_STRIDE + 64 * kt + 32 * ks + 4 * lh;
                        const bf16x4 v0 = *(const LAS bf16x4*)vr, v1 = *(const LAS bf16x4*)(vr + 16);
                        const bf16x8 Vf = {v0[0], v0[1], v0[2], v0[3], v1[0], v1[1], v1[2], v1[3]};
#pragma unroll
                        for (int m = 0; m < 2; ++m) ot[dm][m] = MFMA16(Vf, Pf[m], ot[dm][m]);
                    }
                }
            }
#pragma unroll
            for (int m = 0; m < 2; ++m) {
                const float inv = 1.0f / lrow[m]; const int ql = q0 + 16 * m + li;
                bf16_t* op = cat + (size_t)(tok0 + ql) * DM + 64 * hd + 4 * lh;
#pragma unroll
                for (int dm = 0; dm < 4; ++dm) { const f32x4 o = ot[dm][m] * inv; u32x2 w; w.x = cvt_pk_bf16(o[0], o[1]); w.y = cvt_pk_bf16(o[2], o[3]); *(u32x2*)(op + 16 * dm) = w; }
            }
            }
        }
        LAS bf16_t* Us = (LAS bf16_t*)(lds + POOL_US_OFF); LAS bf16_t* Ds = (LAS bf16_t*)(lds + POOL_DS_OFF); LAS bf16_t* Wp = (LAS bf16_t*)(lds + POOL_W_OFF);
        for (int g = 0; g < 4; ++g) {
            const int w = 2 << g;
            __syncthreads();
            for (int ch = tid; ch < 144 * 16; ch += 512) { const int rr = ch >> 4, c8 = (ch & 15) * 8; const int ts = blk * 128 - 16 + rr;
                bf16x8 v = {0, 0, 0, 0, 0, 0, 0, 0};
                if (ts >= 0) v = *(const bf16x8*)(proj + (size_t)(b * SEQ + ts) * AB_IN + 768 + 128 * g + c8);
                *(LAS bf16x8*)(Us + rr * 128 + c8) = v; }
            { const bf16_t* wsrc = (const bf16_t*)(P.ws + WS_POOLW) + (size_t)(j * 4 + g) * 128 * 128;
              for (int ch = tid; ch < 128 * 16; ch += 512) { const int n = ch >> 4, c8 = (ch & 15) * 8; *(LAS bf16x8*)(Wp + n * 136 + c8) = *(const bf16x8*)(wsrc + n * 128 + c8); } }
            __syncthreads();
            { const int c = tid & 127, tq = tid >> 7; const int t0 = tq * 32;
              float s = 0.f;
              for (int jj = 0; jj < w; ++jj) s += bf2f(Us[(16 + t0 - jj) * 128 + c]);
              for (int t = t0; t < t0 + 32; ++t) {
                  const float ut = bf2f(Us[(16 + t) * 128 + c]);
                  const int cnt = min(blk * 128 + t + 1, w);
                  Ds[t * 136 + c] = f2bf(s / (float)cnt - ut);
                  if (t + 1 < t0 + 32) s += bf2f(Us[(16 + t + 1) * 128 + c]) - bf2f(Us[(16 + t + 1 - w) * 128 + c]);
              } }
            __syncthreads();
            {
                f32x4 pa[8];
#pragma unroll
                for (int nf = 0; nf < 8; ++nf) pa[nf] = (f32x4){0.f, 0.f, 0.f, 0.f};
#pragma unroll
                for (int ks = 0; ks < 4; ++ks) {
                    const bf16x8 df = *(const LAS bf16x8*)(Ds + (16 * wave + li) * 136 + 32 * ks + 8 * lh);
#pragma unroll
                    for (int nf = 0; nf < 8; ++nf) { const bf16x8 wf = *(const LAS bf16x8*)(Wp + (16 * nf + li) * 136 + 32 * ks + 8 * lh); pa[nf] = MFMA16(wf, df, pa[nf]); }
                }
                const float* psc = P.pools + j * 512 + 128 * g;
                bf16_t* op = cat + (size_t)(tok0 + 16 * wave + li) * DM + 512 + 128 * g + 4 * lh;
#pragma unroll
                for (int nf = 0; nf < 8; ++nf) { const f32x4 sc = *(const f32x4*)(psc + 16 * nf + 4 * lh); const f32x4 o = pa[nf] * sc;
                    u32x2 wv; wv.x = cvt_pk_bf16(o[0], o[1]); wv.y = cvt_pk_bf16(o[2], o[3]); *(u32x2*)(op + 16 * nf) = wv; }
            }
        }
    }
    __syncthreads();
}

constexpr int HG_A1 = 0, HG_AP = 8704, HG_BP = 17408, HG_KDT = 26112, HG_VT = 36352, HG_ST = 46592, HG_SC = 81408, HG_TOT = 83968, HG_RED = 86016;

#define HG_BAR() do { asm volatile("s_waitcnt lgkmcnt(0)" ::: "memory"); __builtin_amdgcn_s_barrier(); asm volatile("" ::: "memory"); } while (0)
__device__ void hgrn_phase(LAS unsigned char* lds, const Params& P, int j, int rev) {
    int tid_ = threadIdx.x; asm volatile("" : "+v"(tid_));
    const int tid = tid_, lane = tid & 63, wave = __builtin_amdgcn_readfirstlane(tid >> 6), li = lane & 15, lh = lane >> 4;
    const bf16_t* proj = (const bf16_t*)(P.ws + WS_ACT);
    bf16_t* cat = (bf16_t*)(P.ws + WS_CAT);
    LAS bf16_t* A1s = (LAS bf16_t*)(lds + HG_A1); LAS bf16_t* Aps = (LAS bf16_t*)(lds + HG_AP); LAS bf16_t* Bps = (LAS bf16_t*)(lds + HG_BP);
    LAS bf16_t* KdT = (LAS bf16_t*)(lds + HG_KDT); LAS bf16_t* VT = (LAS bf16_t*)(lds + HG_VT); LAS bf16_t* St = (LAS bf16_t*)(lds + HG_ST);
    LAS bf16_t* Sc = (LAS bf16_t*)(lds + HG_SC); LAS float* tot = (LAS float*)(lds + HG_TOT); LAS float* red = (LAS float*)(lds + HG_RED);
    const int kc = tid & 127, tg = tid >> 7;
    for (int item0 = blockIdx.x; item0 < 256; item0 += gridDim.x) {
        const int item = rev ? 255 - item0 : item0;
        const int b = item >> 3, h = item & 7;
        const float lb = ((const float*)(P.ws + WS_LB))[j * 1024 + h * 128 + kc];
        f32x4 og4 = *(const f32x4*)(P.cog + j * 128 + 16 * wave + 4 * lh);
        __syncthreads();
        for (int i = tid; i < 128 * 136 / 2; i += 512) ((LAS unsigned*)St)[i] = 0u;
        f32x4 Sacc[8];
#pragma unroll
        for (int vf = 0; vf < 8; ++vf) Sacc[vf] = (f32x4){0.f, 0.f, 0.f, 0.f};
        unsigned short rq[8], rf[8], ri[8];
        { const bf16_t* p0 = proj + (size_t)(b * SEQ + 8 * tg) * HG_IN + h * 128 + kc;
#pragma unroll
          for (int e = 0; e < 8; ++e) { rq[e] = p0[(size_t)e * HG_IN]; rf[e] = p0[(size_t)e * HG_IN + 1024]; ri[e] = p0[(size_t)e * HG_IN + 2048]; } }
        for (int c = 0; c < 64; ++c) {
            const size_t crow = (size_t)(b * SEQ + 32 * c);
            float cs[8], kk[8], qt[8];
            { float run = 0.f;
#pragma unroll
              for (int e = 0; e < 8; ++e) { const float z = bf2f(rf[e]); const float sg = fast_sigmoid(z); const float f = lb + (1.0f - lb) * sg;
                  run += __logf(fmaxf(f, 1e-6f)); cs[e] = run; kk[e] = 1.0f - f; const float qv = bf2f(rq[e]); qt[e] = qv * fast_sigmoid(qv); }
              tot[tg * 128 + kc] = run; }
            bf16x4 gt[2];
#pragma unroll
            for (int m = 0; m < 2; ++m) gt[m] = *(const bf16x4*)(proj + (crow + 16 * m + li) * HG_IN + 3072 + h * 128 + 16 * wave + 4 * lh);
            HG_BAR();
            { const float t0 = tot[kc], t1 = tot[128 + kc], t2 = tot[256 + kc], t3 = tot[384 + kc];
              const float pre = (tg > 0 ? t0 : 0.f) + (tg > 1 ? t1 : 0.f) + (tg > 2 ? t2 : 0.f);
              const float gm = t0 + t1, gl = gm + t2 + t3;
              float kd[8], vv[8];
#pragma unroll
              for (int e = 0; e < 8; ++e) { const float G = pre + cs[e]; const int t = 8 * tg + e;
                  A1s[t * 136 + kc] = f2bf(qt[e] * fast_exp(G)); Aps[t * 136 + kc] = f2bf(qt[e] * fast_exp(G - gm)); Bps[t * 136 + kc] = f2bf(kk[e] * fast_exp(gm - G));
                  kd[e] = kk[e] * fast_exp(gl - G); vv[e] = bf2f(ri[e]); }
              *(LAS bf16x8*)(KdT + kc * 40 + 8 * tg) = pack8(kd[0], kd[1], kd[2], kd[3], kd[4], kd[5], kd[6], kd[7]);
              *(LAS bf16x8*)(VT + kc * 40 + 8 * tg) = pack8(vv[0], vv[1], vv[2], vv[3], vv[4], vv[5], vv[6], vv[7]); }
            if (c + 1 < 64) { const bf16_t* p0 = proj + (crow + 32 + 8 * tg) * HG_IN + h * 128 + kc;
#pragma unroll
              for (int e = 0; e < 8; ++e) { rq[e] = p0[(size_t)e * HG_IN]; rf[e] = p0[(size_t)e * HG_IN + 1024]; ri[e] = p0[(size_t)e * HG_IN + 2048]; } }
            HG_BAR();
            float dec[4];
#pragma unroll
            for (int e = 0; e < 4; ++e) { const int k = 16 * wave + 4 * lh + e; dec[e] = fast_exp(tot[k] + tot[128 + k] + tot[256 + k] + tot[384 + k]); }
            f32x4 oacc[2] = {(f32x4){0.f, 0.f, 0.f, 0.f}, (f32x4){0.f, 0.f, 0.f, 0.f}};
#pragma unroll
            for (int ks = 0; ks < 4; ++ks) {
                const bf16x8 sf = *(const LAS bf16x8*)(St + (16 * wave + li) * 136 + 32 * ks + 8 * lh);
#pragma unroll
                for (int m = 0; m < 2; ++m) { const bf16x8 af = *(const LAS bf16x8*)(A1s + (16 * m + li) * 136 + 32 * ks + 8 * lh); oacc[m] = MFMA16(sf, af, oacc[m]); }
            }
            if (wave < 3) {
                const int sfr = (wave == 2) ? 1 : 0, tfr = (wave == 0) ? 0 : 1;
                f32x4 sa = (f32x4){0.f, 0.f, 0.f, 0.f};
#pragma unroll
                for (int ks = 0; ks < 4; ++ks) { const bf16x8 bf = *(const LAS bf16x8*)(Bps + (16 * sfr + li) * 136 + 32 * ks + 8 * lh); const bf16x8 af = *(const LAS bf16x8*)(Aps + (16 * tfr + li) * 136 + 32 * ks + 8 * lh); sa = MFMA16(bf, af, sa); }
                const int t = 16 * tfr + li;
                float sv[4];
#pragma unroll
                for (int e = 0; e < 4; ++e) { const int s = 16 * sfr + 4 * lh + e; sv[e] = (s <= t) ? sa[e] : 0.f; }
                u32x2 w; w.x = cvt_pk_bf16(sv[0], sv[1]); w.y = cvt_pk_bf16(sv[2], sv[3]); *(LAS u32x2*)(Sc + t * 40 + 16 * sfr + 4 * lh) = w;
            } else if (wave == 3) { u32x2 w; w.x = 0u; w.y = 0u; *(LAS u32x2*)(Sc + li * 40 + 16 + 4 * lh) = w; }
            HG_BAR();
            { const bf16x8 vf = *(const LAS bf16x8*)(VT + (16 * wave + li) * 40 + 8 * lh);
#pragma unroll
              for (int m = 0; m < 2; ++m) { const bf16x8 sf = *(const LAS bf16x8*)(Sc + (16 * m + li) * 40 + 8 * lh); oacc[m] = MFMA16(vf, sf, oacc[m]); } }
#pragma unroll
            for (int m = 0; m < 2; ++m) { float ss = 0.f;
#pragma unroll
                for (int e = 0; e < 4; ++e) { const float o = oacc[m][e] * fast_sigmoid(bf2f((unsigned short)gt[m][e])); oacc[m][e] = o; ss += o * o; }
                ss += __shfl_xor(ss, 16); ss += __shfl_xor(ss, 32);
                if (lh == 0) red[wave * 32 + 16 * m + li] = ss; }
            HG_BAR();
#pragma unroll
            for (int m = 0; m < 2; ++m) { const int t = 16 * m + li; float ss = 0.f;
#pragma unroll
                for (int w8 = 0; w8 < 8; ++w8) ss += red[w8 * 32 + t];
                const float rs = __builtin_amdgcn_rsqf(ss * (1.0f / 128.0f) + 1e-6f);
                const f32x4 o = oacc[m] * rs * og4; u32x2 w; w.x = cvt_pk_bf16(o[0], o[1]); w.y = cvt_pk_bf16(o[2], o[3]);
                *(u32x2*)(cat + (crow + t) * DM + h * 128 + 16 * wave + 4 * lh) = w; }
            { const bf16x8 kf = *(const LAS bf16x8*)(KdT + (16 * wave + li) * 40 + 8 * lh);
#pragma unroll
              for (int vf = 0; vf < 8; ++vf) { const bf16x8 vfr = *(const LAS bf16x8*)(VT + (16 * vf + li) * 40 + 8 * lh);
                  f32x4 s = Sacc[vf]; s[0] *= dec[0]; s[1] *= dec[1]; s[2] *= dec[2]; s[3] *= dec[3];
                  s = MFMA16(kf, vfr, s); Sacc[vf] = s;
                  u32x2 w; w.x = cvt_pk_bf16(s[0], s[1]); w.y = cvt_pk_bf16(s[2], s[3]); *(LAS u32x2*)(St + (16 * vf + li) * 136 + 16 * wave + 4 * lh) = w; } }
        }
    }
    __syncthreads();
}


__device__ __forceinline__ void grid_barrier(unsigned* bar, unsigned k) {
    asm volatile("s_waitcnt vmcnt(0)" ::: "memory");
    __syncthreads();
    if (threadIdx.x == 0) {
        const unsigned ngrp = 8u, gsz = gridDim.x / ngrp, g = blockIdx.x % ngrp;
        __builtin_amdgcn_fence(__ATOMIC_RELEASE, "agent");
        asm volatile("s_waitcnt vmcnt(0)" ::: "memory");
        const unsigned old = __hip_atomic_fetch_add(bar + 64 * g, 1u, __ATOMIC_RELAXED, __HIP_MEMORY_SCOPE_AGENT);
        if (old + 1u == gsz * k) __hip_atomic_fetch_add(bar + 64 * ngrp, 1u, __ATOMIC_RELAXED, __HIP_MEMORY_SCOPE_AGENT);
        while (__hip_atomic_load(bar + 64 * ngrp, __ATOMIC_RELAXED, __HIP_MEMORY_SCOPE_AGENT) < ngrp * k) __builtin_amdgcn_s_sleep(1);
        __builtin_amdgcn_fence(__ATOMIC_ACQUIRE, "agent");
        asm volatile("s_waitcnt vmcnt(0)" ::: "memory");
    }
    __syncthreads();
}
__global__ void __launch_bounds__(512, 2) mega(Params P) {
    extern __shared__ __attribute__((aligned(16))) unsigned char lds_raw[];
    LAS unsigned char* lds = (LAS unsigned char*)lds_raw;
    cg::grid_group grid = cg::this_grid();
    unsigned char* ws = P.ws;
    bf16_t* xb = (bf16_t*)(ws + WS_XB); bf16_t* act = (bf16_t*)(ws + WS_ACT); bf16_t* cat = (bf16_t*)(ws + WS_CAT); unsigned* rowss = (unsigned*)(ws + WS_ROWSS);
    for (int p = P.lo; p < P.hi; ++p) {
        const bf16_t* xhA = (const bf16_t*)((p > NPHASE_K - 3) ? (ws + WS_ACT + 384 * MiB) : (unsigned char*)P.out);
        if (p > P.lo) { if (P.hi > 1000000) grid.sync(); else grid_barrier((unsigned*)(ws + WS_BAR), (unsigned)(p - P.lo)); }
        if (p == 0) { phase0(lds, P); continue; }
        const int q = p - 1, layer = q / 7, step = q % 7, jj = layer >> 1; const bool even = (layer & 1) == 0;
        pg8::StaticOrder S;
        if (step == 0 || step == 5) {
            const int s = step == 0 ? 0 : 1;
            pg8::Gemm g{xhA, (const bf16_t*)(ws + WS_WGU) + (size_t)(layer * 2 + s) * 2 * DFF * DM, MTOK, 2 * DFF, DM}; S.init(MTOK, 2 * DFF, gridDim.x, blockIdx.x, p & 1);
            EpiSwiglu E{act, rowss + (size_t)(layer * 3 + (s ? 2 : 0)) * MTOK};
            pg8::gemm_phase<EpiSwiglu, true>(lds, g, S, E);
        } else if (step == 2) {
            const int N = even ? AB_IN : HG_IN;
            const bf16_t* W = even ? (const bf16_t*)(ws + WS_WABIN) + (size_t)jj * DM * AB_IN : (const bf16_t*)(ws + WS_WCIN) + (size_t)jj * DM * HG_IN;
            pg8::Gemm g{xhA, W, MTOK, N, DM}; S.init(MTOK, N, gridDim.x, blockIdx.x, p & 1);
            EpiProj E{act, N, rowss + (size_t)(layer * 3 + 1) * MTOK};
            pg8::gemm_phase<EpiProj, true>(lds, g, S, E);
        } else if (step == 3) {
            for (int rep = 0; rep < REP_MIX; ++rep) { if (even) attn_pool_phase(lds, P, jj, p & 1); else hgrn_phase(lds, P, jj, p & 1); }
        } else {
            const bf16_t* A; const bf16_t* W; int K; float scale; int nid;
            if (step == 4) { A = cat; W = even ? (const bf16_t*)(ws + WS_WABOUT) + (size_t)jj * DM * DM : (const bf16_t*)(ws + WS_WCOUT) + (size_t)jj * DM * DM; K = DM; scale = 1.0f; nid = layer * 3 + 2; }
            else { const int s = step == 1 ? 0 : 1; A = act; W = (const bf16_t*)(ws + WS_WDN) + (size_t)(layer * 2 + s) * DFF * DM; K = DFF; scale = 0.5f; nid = s ? (layer + 1) * 3 : layer * 3 + 1; }
            pg8::Gemm g{A, W, MTOK, DM, K}; S.init(MTOK, DM, gridDim.x, blockIdx.x, p & 1);
            _Float16* xh_main = (_Float16*)P.out; _Float16* xh_alt = (_Float16*)(ws + WS_ACT + 384 * MiB);
            if (p == NPHASE_K - 1) { EpiResid<true> E{xh_alt, nullptr, P.out, nullptr, nullptr, scale, lds}; pg8::gemm_phase<EpiResid<true>>(lds, g, S, E); }
            else { EpiResid<false> E{xh_main, (p == NPHASE_K - 3) ? xh_alt : xh_main, nullptr, xb, rowss + (size_t)nid * MTOK, scale, lds}; pg8::gemm_phase<EpiResid<false>>(lds, g, S, E); }
        }
    }
}

constexpr int NPHASE = 29;
#ifndef NRUN
#define NRUN 29
#endif

extern "C" void kernel_launch(void* const* d_in, const int* in_sizes, int n_in, void* d_out, int out_size, void* d_ws, size_t ws_size, hipStream_t stream) {
    static int grid = 0;
    if (grid == 0) {
        if (n_in != 17 || out_size != MTOK * DM || ws_size < WS_END) { fprintf(stderr, "kernel_launch: unexpected shapes (n_in %d out %d ws %zu)\n", n_in, out_size, ws_size); grid = -1; return; }
        int dev = 0, cus = 0, per_cu = 0;
        hipGetDevice(&dev); hipDeviceGetAttribute(&cus, hipDeviceAttributeMultiprocessorCount, dev);
        if (hipFuncSetAttribute((const void*)mega, hipFuncAttributeMaxDynamicSharedMemorySize, LDS_BYTES) != hipSuccess) { fprintf(stderr, "kernel_launch: hipFuncSetAttribute failed\n"); grid = -1; return; }
        if (hipOccupancyMaxActiveBlocksPerMultiprocessor(&per_cu, (const void*)mega, 512, LDS_BYTES) != hipSuccess || per_cu < 1) { fprintf(stderr, "kernel_launch: occupancy query says %d\n", per_cu); per_cu = 1; }
        (void)hipGetLastError();
        grid = cus;
    }
    if (grid < 0) return;
    Params p{};
    p.x = (const float*)d_in[0]; p.pos = (const int*)d_in[1]; p.ng = (const float*)d_in[2]; p.wg = (const float*)d_in[3]; p.wu = (const float*)d_in[4]; p.wd = (const float*)d_in[5];
    p.abin = (const float*)d_in[6]; p.about = (const float*)d_in[7]; p.qg = (const float*)d_in[8]; p.kg = (const float*)d_in[9]; p.sinks = (const float*)d_in[10];
    p.poolw = (const float*)d_in[11]; p.pools = (const float*)d_in[12]; p.cin = (const float*)d_in[13]; p.cout = (const float*)d_in[14]; p.cog = (const float*)d_in[15]; p.lbl = (const float*)d_in[16];
    p.out = (float*)d_out; p.ws = (unsigned char*)d_ws;
#if ONE_LAUNCH
    p.lo = 0; p.hi = NPHASE;
    (void)hipMemsetAsync((unsigned char*)d_ws + WS_BAR, 0, 9 * 256, stream);
    void* args[] = {&p};
    hipError_t e = hipLaunchCooperativeKernel((const void*)mega, dim3(grid), dim3(512), args, LDS_BYTES, stream);
    if (e != hipSuccess) fprintf(stderr, "cooperative launch failed: %s (grid %d)\n", hipGetErrorString(e), grid);
#else
    for (int ph = 0; ph < NRUN; ++ph) { p.lo = ph; p.hi = ph + 1; hipLaunchKernelGGL(mega, dim3(grid), dim3(512), LDS_BYTES, stream, p); }
#endif
}
```

```cpp
#include <hip/hip_runtime.h>
#include <hip/hip_cooperative_groups.h>
#include <cstdio>
namespace cg = cooperative_groups;

#ifndef REP_MIX
#define REP_MIX 1
#endif
#ifndef ONE_LAUNCH
#define ONE_LAUNCH 1
#endif

#define LAS __attribute__((address_space(3)))
typedef unsigned short bf16_t;
typedef short bf16x8 __attribute__((ext_vector_type(8)));
typedef short bf16x4 __attribute__((ext_vector_type(4)));
typedef float f32x4 __attribute__((ext_vector_type(4)));
typedef float f32x2 __attribute__((ext_vector_type(2)));
typedef unsigned u32x4 __attribute__((ext_vector_type(4)));
typedef unsigned u32x2 __attribute__((ext_vector_type(2)));
typedef _Float16 f16x2_t __attribute__((ext_vector_type(2)));
typedef _Float16 f16x4_t __attribute__((ext_vector_type(4)));
typedef _Float16 f16x8_t __attribute__((ext_vector_type(8)));

constexpr int MTOK = 65536, DM = 1024, DFF = 2816, SEQ = 2048, NB = 32;
constexpr int AB_IN = 1280, HG_IN = 4096;
constexpr int LDS_BYTES = 131072 + 4096 + 2048;

constexpr size_t MiB = 1024ull * 1024ull;
constexpr size_t WS_XB = 0;
constexpr size_t WS_ACT = 128 * MiB;
constexpr size_t WS_CAT = 640 * MiB;
constexpr size_t WS_WGU = 768 * MiB;
constexpr size_t WS_WDN = 856 * MiB;
constexpr size_t WS_WABIN = 900 * MiB;
constexpr size_t WS_WABOUT = 905 * MiB;
constexpr size_t WS_WCIN = 909 * MiB;
constexpr size_t WS_WCOUT = 925 * MiB;
constexpr size_t WS_POOLW = 929 * MiB;
constexpr size_t WS_ROWSS = 930 * MiB;
constexpr size_t WS_ROPE = 938 * MiB;
constexpr size_t WS_LB = 939 * MiB;
constexpr size_t WS_BAR = 940 * MiB;
constexpr size_t WS_END = 941 * MiB;

constexpr int NPHASE_K = 29;
struct Params {
    const float* x; const int* pos; const float* ng; const float* wg; const float* wu; const float* wd;
    const float* abin; const float* about; const float* qg; const float* kg; const float* sinks; const float* poolw; const float* pools;
    const float* cin; const float* cout; const float* cog; const float* lbl;
    float* out; unsigned char* ws; int lo, hi;
};

__device__ __forceinline__ float bf2f(unsigned short b) { return __uint_as_float(((unsigned)b) << 16); }
typedef __bf16 bf16x2_t __attribute__((ext_vector_type(2)));
__device__ __forceinline__ unsigned cvt_pk_bf16(float lo, float hi) { f32x2 v = {lo, hi}; bf16x2_t r = __builtin_convertvector(v, bf16x2_t); return __builtin_bit_cast(unsigned, r); }
__device__ __forceinline__ unsigned cvt_pk_f16(float lo, float hi) { f32x2 v = {lo, hi}; f16x2_t r = __builtin_convertvector(v, f16x2_t); return __builtin_bit_cast(unsigned, r); }
__device__ __forceinline__ bf16_t f2bf(float f) { return (bf16_t)(cvt_pk_bf16(f, 0.f) & 0xffffu); }
__device__ __forceinline__ bf16x8 pack8(float a0, float a1, float a2, float a3, float a4, float a5, float a6, float a7) {
    u32x4 w; w.x = cvt_pk_bf16(a0, a1); w.y = cvt_pk_bf16(a2, a3); w.z = cvt_pk_bf16(a4, a5); w.w = cvt_pk_bf16(a6, a7); return __builtin_bit_cast(bf16x8, w); }
__device__ __forceinline__ float fast_exp(float x) { return __builtin_amdgcn_exp2f(x * 1.4426950408889634f); }
__device__ __forceinline__ float fast_sigmoid(float x) { return __builtin_amdgcn_rcpf(1.0f + fast_exp(-x)); }
#define MFMA16(a, b, c) __builtin_amdgcn_mfma_f32_16x16x32_bf16((a), (b), (c), 0, 0, 0)

namespace pg8 {
constexpr int BM = 256, BK = 64, HALF = 128, HTB = HALF * BK * 2, STAGE_BYTES = 8 * HTB, NXCD = 8, WGM = 8;
__device__ __forceinline__ int lds_byte(int r, int c) { const int st = (r >> 4) * 2 + (c >> 5), rr = r & 15, cc = c & 31, ob = rr * 64 + cc * 2; return st * 1024 + (ob ^ (((ob >> 9) & 1) << 5)); }
__device__ __forceinline__ void stage_rc(int b, int& R, int& C) { const int st = b / 1024, sb = b % 1024, swz = sb ^ (((sb >> 9) & 1) << 5); R = (st >> 1) * 16 + swz / 64; C = (st & 1) * 32 + (swz % 64) / 2; }
__device__ __forceinline__ int perm32(int rho) { const int n = rho >> 4, i = rho & 15; return 8 * (i >> 2) + 4 * n + (i & 3); }
struct Unit { int pm, pn; };
struct Gemm { const bf16_t* A; const bf16_t* Bt; int M, N, K; };
struct StaticOrder {
    int nM, nN, nwg, G, c, rev;
    __device__ void init(int M, int N, int G_, int c_, int rev_ = 0) { nM = M / BM; nN = N / BM; nwg = nM * nN; G = G_; c = c_; rev = rev_; }
    __device__ bool next(int i, Unit& u) const {
        long L = (long)i * G + c; if (L >= nwg) return false;
        if (rev) L = nwg - 1 - L;
        int wgid = (int)L; { const int q = nwg / NXCD, r = nwg % NXCD, xcd = wgid % NXCD, off = wgid / NXCD; wgid = (xcd < r ? xcd * (q + 1) : r * (q + 1) + (xcd - r) * q) + off; }
        const int nig = WGM * nN, gid = wgid / nig, fm = gid * WGM, gsz = (nM - fm) < WGM ? (nM - fm) : WGM;
        u.pm = fm + ((wgid % nig) % gsz); u.pn = (wgid % nig) / gsz; return true;
    }
};

template <class Epi, bool F16 = false>
__device__ __forceinline__ void gemm_phase(LAS unsigned char* lds, const Gemm g, const StaticOrder& S, const Epi& E) {
    int tid_ = threadIdx.x; asm volatile("" : "+v"(tid_));
    const int tid = tid_, wid = __builtin_amdgcn_readfirstlane(tid >> 6), lane = tid & 63, wr = wid >> 2, wc = wid & 3, fr = lane & 15, fq = lane >> 4;
    const int K = g.K, nt = K / BK;
    unsigned voffA[2], voffB[2];
#pragma unroll
    for (int i = 0; i < 2; ++i) { int R, C; stage_rc(tid * 16 + i * 8192, R, C); const int Rb = Epi::PERM ? ((R & ~31) + perm32(R & 31)) : R;
        voffA[i] = (unsigned)(R * K + C) * 2u; voffB[i] = (unsigned)(Rb * K + C) * 2u; }
    const long kstep = (long)(BK * 2);
    const size_t hstep = (size_t)HALF * K * 2;
    const size_t tstep = 2 * hstep;
    const unsigned ldsw = (unsigned)wid * 1024u;
    const int aoff = lds_byte(wr * 64 + fr, fq * 8), boff = lds_byte(wc * 32 + fr, fq * 8);
#define PG8_SA(b, h) (((b) * 2 + (h)) * HTB)
#define PG8_SB(b, h) ((4 + (b) * 2 + (h)) * HTB)
#define PG8_STAGE(bufoff, gbase, voff) do { _Pragma("unroll") for (int _i = 0; _i < 2; ++_i) \
        __builtin_amdgcn_global_load_lds((const unsigned*)((const char*)(gbase) + (voff)[_i]), (LAS unsigned*)(lds + (bufoff) + ldsw + _i * 8192), 16, 0, 0); } while (0)
#define PG8_LDA(dst, b, h) do { _Pragma("unroll") for (int m = 0; m < 4; ++m) _Pragma("unroll") for (int k = 0; k < 2; ++k) dst[m][k] = *(const LAS bf16x8*)(lds + PG8_SA(b, h) + aoff + m * 2048 + k * 1024); } while (0)
#define PG8_LDB(dst, b, h) do { _Pragma("unroll") for (int n = 0; n < 2; ++n) _Pragma("unroll") for (int k = 0; k < 2; ++k) dst[n][k] = *(const LAS bf16x8*)(lds + PG8_SB(b, h) + boff + n * 2048 + k * 1024); } while (0)
#define PG8_MMA(ai, bj, At, Bt) do { __builtin_amdgcn_s_setprio(1); _Pragma("unroll") for (int m = 0; m < 4; ++m) _Pragma("unroll") for (int n = 0; n < 2; ++n) _Pragma("unroll") for (int k = 0; k < 2; ++k) \
        acc[ai][bj][m][n] = F16 ? __builtin_amdgcn_mfma_f32_16x16x32_f16(__builtin_bit_cast(f16x8_t, Bt[n][k]), __builtin_bit_cast(f16x8_t, At[m][k]), acc[ai][bj][m][n], 0, 0, 0) \
                                : __builtin_amdgcn_mfma_f32_16x16x32_bf16(Bt[n][k], At[m][k], acc[ai][bj][m][n], 0, 0, 0); __builtin_amdgcn_s_setprio(0); } while (0)
#define PG8_WAIT_V(n) asm volatile("s_waitcnt vmcnt(" #n ")" ::: "memory")
#define PG8_WAIT_L(n) asm volatile("s_waitcnt lgkmcnt(" #n ")" ::: "memory")
#define PG8_BAR __builtin_amdgcn_s_barrier()
#define PG8_SCHED __builtin_amdgcn_sched_barrier(0)
    Unit cur, nxt; int ui = 0;
    if (!S.next(0, cur)) return;
    f32x4 acc[2][2][4][2];
#pragma unroll
    for (int a = 0; a < 2; ++a)
#pragma unroll
        for (int b = 0; b < 2; ++b)
#pragma unroll
            for (int m = 0; m < 4; ++m)
#pragma unroll
                for (int n = 0; n < 2; ++n) acc[a][b][m][n] = (f32x4){0.f, 0.f, 0.f, 0.f};
    bf16x8 At[4][2], B0[2][2], B1[2][2];
    typename Epi::Pre pre; LAS unsigned char* const pretab = lds + 131072 + 4096;
    E.prefetch_lds(pretab, cur, wid, lane);
    const char* cA = (const char*)g.A + (size_t)cur.pm * tstep; const char* cB = (const char*)g.Bt + (size_t)cur.pn * tstep;
    int ck = (int)kstep;
    PG8_STAGE(PG8_SB(0, 0), cB, voffB); PG8_STAGE(PG8_SA(0, 0), cA, voffA); PG8_STAGE(PG8_SB(0, 1), cB + hstep, voffB); PG8_STAGE(PG8_SA(0, 1), cA + hstep, voffA);
    if (wr == 1) PG8_BAR;
    PG8_WAIT_V(4); PG8_BAR;
    PG8_STAGE(PG8_SB(1, 0), cB + kstep, voffB); PG8_STAGE(PG8_SA(1, 0), cA + kstep, voffA); PG8_STAGE(PG8_SB(1, 1), cB + hstep + kstep, voffB);
    PG8_WAIT_V(6); PG8_BAR;
    for (;;) {
        const bool has_next = S.next(ui + 1, nxt);
        const int nk = has_next ? -ck : ck; const int nofs = (has_next && nk < 0) ? (nt - 1) * (int)kstep : 0;
        const char* nA = has_next ? (const char*)g.A + (size_t)nxt.pm * tstep + nofs : cA; const char* nB = has_next ? (const char*)g.Bt + (size_t)nxt.pn * tstep + nofs : cB;
        for (int t = 0; t < nt; t += 2) {
            const bool last = (t == nt - 2);
            const char* a1 = cA + (t + 1) * ck;
            const char* a2 = last ? nA : cA + (t + 2) * ck; const char* b2 = last ? nB : cB + (t + 2) * ck;
            const int k3 = last ? nk : ck; const char* a3 = a2 + k3; const char* b3 = b2 + k3;
            PG8_LDB(B0, 0, 0); PG8_SCHED; PG8_LDA(At, 0, 0); PG8_STAGE(PG8_SA(1, 1), a1 + hstep, voffA);
            PG8_WAIT_L(8); PG8_BAR; PG8_WAIT_L(0); PG8_MMA(0, 0, At, B0); PG8_BAR; PG8_SCHED;
            PG8_LDB(B1, 0, 1); PG8_STAGE(PG8_SB(0, 0), b2, voffB);
            PG8_BAR; PG8_WAIT_L(0); PG8_MMA(0, 1, At, B1); PG8_BAR;
            PG8_LDA(At, 0, 1); PG8_STAGE(PG8_SA(0, 0), a2, voffA);
            PG8_BAR; PG8_WAIT_L(0); PG8_MMA(1, 0, At, B0); PG8_BAR; PG8_SCHED;
            PG8_STAGE(PG8_SB(0, 1), b2 + hstep, voffB);
            PG8_WAIT_V(6); PG8_BAR; PG8_MMA(1, 1, At, B1); PG8_BAR;
            PG8_LDB(B0, 1, 0); PG8_SCHED; PG8_LDA(At, 1, 0); PG8_STAGE(PG8_SA(0, 1), a2 + hstep, voffA);
            PG8_WAIT_L(8); PG8_BAR; PG8_WAIT_L(0); PG8_MMA(0, 0, At, B0); PG8_BAR; PG8_SCHED;
            PG8_LDB(B1, 1, 1); PG8_STAGE(PG8_SB(1, 0), b3, voffB);
            PG8_BAR; PG8_WAIT_L(0); PG8_MMA(0, 1, At, B1); PG8_BAR;
            PG8_LDA(At, 1, 1); PG8_STAGE(PG8_SA(1, 0), a3, voffA);
            PG8_BAR; PG8_WAIT_L(0); PG8_MMA(1, 0, At, B0); PG8_BAR; PG8_SCHED;
            PG8_STAGE(PG8_SB(1, 1), b3 + hstep, voffB);
            PG8_WAIT_V(6); PG8_BAR; PG8_MMA(1, 1, At, B1); PG8_BAR;
        }
        E.fetch_pre(pre, pretab + (ui & 1) * 1024, wr, fr);
        E(acc, pre, cur, wr, wc, fr, fq);
        if (!has_next) break;
        E.prefetch_lds(pretab + ((ui + 1) & 1) * 1024, nxt, wid, lane);
#pragma unroll
        for (int a = 0; a < 2; ++a)
#pragma unroll
            for (int b = 0; b < 2; ++b)
#pragma unroll
                for (int m = 0; m < 4; ++m)
#pragma unroll
                    for (int n = 0; n < 2; ++n) acc[a][b][m][n] = (f32x4){0.f, 0.f, 0.f, 0.f};
        cur = nxt; cA = nA; cB = nB; ck = nk; ++ui;
    }
    PG8_WAIT_V(0);
    if (wr == 0) PG8_BAR;
    PG8_BAR;
#undef PG8_SA
#undef PG8_SB
#undef PG8_STAGE
#undef PG8_LDA
#undef PG8_LDB
#undef PG8_MMA
#undef PG8_WAIT_V
#undef PG8_WAIT_L
#undef PG8_BAR
#undef PG8_SCHED
}
}

struct EpiSwiglu {
    static constexpr bool PERM = true;
    bf16_t* O; const unsigned* rowss;
    struct Pre { unsigned v[8]; };
    static constexpr bool LDS_PRE = true;
    __device__ __forceinline__ void prefetch_lds(LAS unsigned char* tab, const pg8::Unit& u, int wid, int lane) const {
        if (wid < 4) __builtin_amdgcn_global_load_lds((const unsigned*)(rowss + u.pm * 256 + wid * 64 + lane), (LAS unsigned*)(tab + wid * 256), 4, 0, 0); }
    __device__ __forceinline__ void fetch_pre(Pre& pre, const LAS unsigned char* tab, int wr, int fr) const {
#pragma unroll
        for (int i = 0; i < 8; ++i) pre.v[i] = ((const LAS unsigned*)tab)[(i >> 2) * 128 + wr * 64 + (i & 3) * 16 + fr]; }
    __device__ __forceinline__ void operator()(const f32x4 (&acc)[2][2][4][2], const Pre& pre, const pg8::Unit& u, int wr, int wc, int fr, int fq) const {
        const int row0 = u.pm * 256 + wr * 64 + fr, h0 = u.pn * 128 + wc * 32 + 8 * fq;
#pragma unroll
        for (int ai = 0; ai < 2; ++ai)
#pragma unroll
            for (int m = 0; m < 4; ++m) {
                const int r = row0 + ai * 128 + m * 16;
                const float rs = __builtin_amdgcn_rsqf((float)pre.v[ai * 4 + m] * (1.0f / (1024.0f * 1024.0f)) + 1e-6f);
                float o[8];
#pragma unroll
                for (int n = 0; n < 2; ++n)
#pragma unroll
                    for (int j = 0; j < 4; ++j) { const float gv = acc[ai][0][m][n][j] * rs, uv = acc[ai][1][m][n][j] * rs; o[n * 4 + j] = gv * uv * fast_sigmoid(gv); }
                u32x4 w; w.x = cvt_pk_bf16(o[0], o[1]); w.y = cvt_pk_bf16(o[2], o[3]); w.z = cvt_pk_bf16(o[4], o[5]); w.w = cvt_pk_bf16(o[6], o[7]);
                *(u32x4*)(O + (size_t)r * DFF + h0) = w;
            }
    }
};
struct EpiProj {
    static constexpr bool PERM = true;
    bf16_t* O; int ldc; const unsigned* rowss;
    struct Pre { unsigned v[8]; };
    static constexpr bool LDS_PRE = true;
    __device__ __forceinline__ void prefetch_lds(LAS unsigned char* tab, const pg8::Unit& u, int wid, int lane) const {
        if (wid < 4) __builtin_amdgcn_global_load_lds((const unsigned*)(rowss + u.pm * 256 + wid * 64 + lane), (LAS unsigned*)(tab + wid * 256), 4, 0, 0); }
    __device__ __forceinline__ void fetch_pre(Pre& pre, const LAS unsigned char* tab, int wr, int fr) const {
#pragma unroll
        for (int i = 0; i < 8; ++i) pre.v[i] = ((const LAS unsigned*)tab)[(i >> 2) * 128 + wr * 64 + (i & 3) * 16 + fr]; }
    __device__ __forceinline__ void operator()(const f32x4 (&acc)[2][2][4][2], const Pre& pre, const pg8::Unit& u, int wr, int wc, int fr, int fq) const {
        const int row0 = u.pm * 256 + wr * 64 + fr, col0 = u.pn * 256 + wc * 32 + 8 * fq;
#pragma unroll
        for (int ai = 0; ai < 2; ++ai)
#pragma unroll
            for (int m = 0; m < 4; ++m) {
                const int r = row0 + ai * 128 + m * 16;
                const float rs = __builtin_amdgcn_rsqf((float)pre.v[ai * 4 + m] * (1.0f / (1024.0f * 1024.0f)) + 1e-6f);
#pragma unroll
                for (int bj = 0; bj < 2; ++bj) {
                    const f32x4 v0 = acc[ai][bj][m][0] * rs, v1 = acc[ai][bj][m][1] * rs;
                    u32x4 w; w.x = cvt_pk_bf16(v0[0], v0[1]); w.y = cvt_pk_bf16(v0[2], v0[3]); w.z = cvt_pk_bf16(v1[0], v1[1]); w.w = cvt_pk_bf16(v1[2], v1[3]);
                    *(u32x4*)(O + (size_t)r * ldc + col0 + bj * 128) = w;
                }
            }
    }
};
template <bool FINAL> struct EpiResid {
    static constexpr bool PERM = true;
    const _Float16* xin; _Float16* xout; float* outf; bf16_t* xb; unsigned* rowss_next; float scale; LAS unsigned char* lds;
    struct Pre { };
    static constexpr bool LDS_PRE = false;
    __device__ __forceinline__ void prefetch_lds(LAS unsigned char*, const pg8::Unit&, int, int) const {}
    __device__ __forceinline__ void fetch_pre(Pre&, const LAS unsigned char*, int, int) const {}
    __device__ __forceinline__ void operator()(const f32x4 (&acc)[2][2][4][2], const Pre&, const pg8::Unit& u, int wr, int wc, int fr, int fq) const {
        const int row0 = u.pm * 256 + wr * 64 + fr, col0 = u.pn * 256 + wc * 32 + 8 * fq;
        f16x8_t xc[2][4][2];
#pragma unroll
        for (int m = 0; m < 4; ++m) { const _Float16* xp = xin + (size_t)(row0 + m * 16) * DM + col0;
#pragma unroll
            for (int bj = 0; bj < 2; ++bj) xc[0][m][bj] = *(const f16x8_t*)(xp + bj * 128); }
#pragma unroll
        for (int m = 0; m < 2; ++m) { const _Float16* xp = xin + (size_t)(row0 + 128 + m * 16) * DM + col0;
#pragma unroll
            for (int bj = 0; bj < 2; ++bj) xc[1][m][bj] = *(const f16x8_t*)(xp + bj * 128); }
        asm volatile("" ::: "memory");
#pragma unroll
        for (int ai = 0; ai < 2; ++ai)
#pragma unroll
            for (int m = 0; m < 4; ++m) {
                if (ai == 0 && m == 1) {
#pragma unroll
                    for (int m2 = 2; m2 < 4; ++m2) { const _Float16* xp = xin + (size_t)(row0 + 128 + m2 * 16) * DM + col0;
#pragma unroll
                        for (int bj = 0; bj < 2; ++bj) xc[1][m2][bj] = *(const f16x8_t*)(xp + bj * 128); }
                }
                const int r = row0 + ai * 128 + m * 16; const size_t off = (size_t)r * DM + col0; float ss = 0.f;
#pragma unroll
                for (int bj = 0; bj < 2; ++bj) {
                    const f16x8_t xv = xc[ai][m][bj];
                    const f32x4 x0 = {(float)xv[0], (float)xv[1], (float)xv[2], (float)xv[3]}, x1 = {(float)xv[4], (float)xv[5], (float)xv[6], (float)xv[7]};
                    const f32x4 o0 = x0 + acc[ai][bj][m][0] * scale, o1 = x1 + acc[ai][bj][m][1] * scale;
                    if (FINAL) { *(f32x4*)(outf + off + bj * 128) = o0; *(f32x4*)(outf + off + bj * 128 + 4) = o1; }
                    else {
                        const f16x4_t h0 = __builtin_convertvector(o0, f16x4_t), h1 = __builtin_convertvector(o1, f16x4_t);
                        const f16x8_t hv = {h0[0], h0[1], h0[2], h0[3], h1[0], h1[1], h1[2], h1[3]};
                        *(f16x8_t*)(xout + off + bj * 128) = hv;
                        ss += (o0[0] * o0[0] + o0[1] * o0[1]) + (o0[2] * o0[2] + o0[3] * o0[3]) + (o1[0] * o1[0] + o1[1] * o1[1]) + (o1[2] * o1[2] + o1[3] * o1[3]);
                    }
                }
                if (!FINAL) { ss += __shfl_xor(ss, 16); ss += __shfl_xor(ss, 32);
                    if (fq == 0) ((LAS float*)(lds + 131072))[((wr * 4 + wc) * 8 + ai * 4 + m) * 16 + fr] = ss; }
            }
        if (!FINAL) {
            asm volatile("s_waitcnt lgkmcnt(0)" ::: "memory"); __builtin_amdgcn_s_barrier(); asm volatile("" ::: "memory");
            if (wc == 0) {
                const int lane = fq * 16 + fr;
#pragma unroll
                for (int hh = 0; hh < 2; ++hh) {
                    const int idx = hh * 64 + lane, g = idx >> 4, f = idx & 15;
                    float t = 0.f;
#pragma unroll
                    for (int w4 = 0; w4 < 4; ++w4) t += ((const LAS float*)(lds + 131072))[((wr * 4 + w4) * 8 + g) * 16 + f];
                    atomicAdd(rowss_next + u.pm * 256 + (g >> 2) * 128 + wr * 64 + (g & 3) * 16 + f, (unsigned)(t * 1024.0f + 0.5f));
                }
            }
        }
    }
};

__device__ __forceinline__ void get_job(const Params& P, int id, const float*& src, bf16_t*& dst, const float*& gain, int& K, int& N, int& mode) {
    unsigned char* ws = P.ws; gain = nullptr; mode = 0;
    if (id < 16) { const int which = id >> 3, ls = id & 7, l = ls >> 1, s = ls & 1;
        src = (which ? P.wu : P.wg) + (size_t)ls * DM * DFF; dst = (bf16_t*)(ws + WS_WGU) + (size_t)ls * 2 * DFF * DM; gain = P.ng + (l * 3 + (s ? 2 : 0)) * DM; K = DM; N = DFF; mode = 1 + which; }
    else if (id < 24) { const int ls = id - 16; src = P.wd + (size_t)ls * DFF * DM; dst = (bf16_t*)(ws + WS_WDN) + (size_t)ls * DFF * DM; K = DFF; N = DM; }
    else if (id < 26) { const int j = id - 24; src = P.abin + (size_t)j * DM * AB_IN; dst = (bf16_t*)(ws + WS_WABIN) + (size_t)j * DM * AB_IN; gain = P.ng + ((2 * j) * 3 + 1) * DM; K = DM; N = AB_IN; }
    else if (id < 28) { const int j = id - 26; src = P.about + (size_t)j * DM * DM; dst = (bf16_t*)(ws + WS_WABOUT) + (size_t)j * DM * DM; K = DM; N = DM; }
    else if (id < 30) { const int j = id - 28; src = P.cin + (size_t)j * DM * HG_IN; dst = (bf16_t*)(ws + WS_WCIN) + (size_t)j * DM * HG_IN; gain = P.ng + ((2 * j + 1) * 3 + 1) * DM; K = DM; N = HG_IN; }
    else if (id < 32) { const int j = id - 30; src = P.cout + (size_t)j * DM * DM; dst = (bf16_t*)(ws + WS_WCOUT) + (size_t)j * DM * DM; K = DM; N = DM; }
    else { const int j = id - 32; src = P.poolw + (size_t)j * 128 * 128; dst = (bf16_t*)(ws + WS_POOLW) + (size_t)j * 128 * 128; K = 128; N = 128; }
}

__device__ void phase0(LAS unsigned char* lds, const Params& P) {
    int tid_ = threadIdx.x; asm volatile("" : "+v"(tid_));
    const int tid = tid_, lane = tid & 63, wave = tid >> 6, G = gridDim.x, bid = blockIdx.x;
    LAS float* tile = (LAS float*)lds;
    for (int id = 0; id < 40; ++id) {
        const float* src; bf16_t* dst; const float* gain; int K, N, mode;
        get_job(P, id, src, dst, gain, K, N, mode);
        const int ntn = N >> 6, ntiles = (K >> 6) * ntn;
        for (int t = bid; t < ntiles; t += G) {
            const int k0 = (t / ntn) << 6, n0 = (t % ntn) << 6;
#pragma unroll
            for (int p = 0; p < 2; ++p) { const int idx = p * 512 + tid, kk = idx >> 4, n4 = (idx & 15) * 4;
                f32x4 v = *(const f32x4*)(src + (size_t)(k0 + kk) * N + n0 + n4); if (gain) v *= gain[k0 + kk];
                tile[kk * 65 + n4] = v[0]; tile[kk * 65 + n4 + 1] = v[1]; tile[kk * 65 + n4 + 2] = v[2]; tile[kk * 65 + n4 + 3] = v[3]; }
            __syncthreads();
#pragma unroll
            for (int p = 0; p < 4; ++p) { const int idx = p * 512 + tid, nn = idx >> 5, kk = (idx & 31) * 2, n = n0 + nn;
                const int drow = mode == 0 ? n : ((n >> 7) * 256 + (n & 127) + (mode == 2 ? 128 : 0));
                const float w0 = tile[kk * 65 + nn], w1 = tile[(kk + 1) * 65 + nn];
                const unsigned wb = cvt_pk_bf16(w0, w1);
                *(unsigned*)(dst + (size_t)drow * K + k0 + kk) = gain ? cvt_pk_f16(__uint_as_float(wb << 16), __uint_as_float(wb & 0xffff0000u)) : wb; }
            __syncthreads();
        }
    }
    bf16_t* xb = (bf16_t*)(P.ws + WS_XB); unsigned* rowss = (unsigned*)(P.ws + WS_ROWSS);
    for (int row0 = (bid * 8 + wave) * 2; row0 < MTOK; row0 += G * 16) {
        f32x4 v[2][4];
#pragma unroll
        for (int rr = 0; rr < 2; ++rr)
#pragma unroll
            for (int i = 0; i < 4; ++i) v[rr][i] = ((const f32x4*)(P.x + (size_t)(row0 + rr) * DM))[lane + 64 * i];
#pragma unroll
        for (int rr = 0; rr < 2; ++rr) { float s = 0.f;
#pragma unroll
            for (int i = 0; i < 4; ++i) { const f32x4 t = v[rr][i]; s += (t[0] * t[0] + t[1] * t[1]) + (t[2] * t[2] + t[3] * t[3]);
                *(f16x4_t*)((_Float16*)P.out + (size_t)(row0 + rr) * DM + 4 * (lane + 64 * i)) = __builtin_convertvector(t, f16x4_t); }
#pragma unroll
            for (int o = 32; o >= 1; o >>= 1) s += __shfl_xor(s, o);
            if (lane == 0) rowss[row0 + rr] = (unsigned)(s * 1024.0f + 0.5f); }
    }
    const int gtid = bid * 512 + tid, gthr = G * 512;
#pragma unroll 1
    for (int base = 0; base < 11 * MTOK; base += gthr) { const int i = base + gtid; if (i < 11 * MTOK) rowss[MTOK + i] = 0u; }
    f32x2* rope = (f32x2*)(P.ws + WS_ROPE);
#pragma unroll 1
    for (int base = 0; base < SEQ * 32; base += gthr) { const int i = base + gtid; if (i >= SEQ * 32) break;
        const int t = i >> 5, fi = i & 31;
        const float inv = exp2f(-(float)fi * (13.287712379549449f / 32.0f));
        const float ang = (float)P.pos[t] * inv;
        const double rev = (double)ang * 0.15915494309189535; const float fr = (float)(rev - floor(rev));
        rope[i] = (f32x2){__builtin_amdgcn_cosf(fr), __builtin_amdgcn_sinf(fr)};
    }
    float* lb = (float*)(P.ws + WS_LB);
#pragma unroll 1
    for (int base = 0; base < 1024; base += gthr) { const int i = base + gtid; if (i >= 1024) break; const float l0 = P.lbl[i], l1 = P.lbl[1024 + i]; const float mx = fmaxf(l0, l1);
        const float e0 = expf(l0 - mx), e1 = expf(l1 - mx); const float p0 = e0 / (e0 + e1), p1 = e1 / (e0 + e1); lb[i] = p0 - p0; lb[1024 + i] = (p0 + p1) - p0; }
}

constexpr int KS_STRIDE = 72;
constexpr int VT_STRIDE = 264;
constexpr int ATT_KS_OFF = 0, ATT_VT_OFF = 256 * KS_STRIDE * 2;
constexpr int POOL_US_OFF = 0, POOL_DS_OFF = 144 * 128 * 2, POOL_W_OFF = POOL_DS_OFF + 128 * 136 * 2;

__device__ __forceinline__ void rope8r(bf16x8 a, bf16x8 c, float rs, const float* g, const f32x2* ropep, int fi0, bf16x8& r1, bf16x8& r2) {
    float o1[8], o2[8];
#pragma unroll
    for (int e = 0; e < 8; ++e) { const f32x2 cs = ropep[fi0 + e];
        const float y1 = bf2f((unsigned short)a[e]) * rs * g[fi0 + e], y2 = bf2f((unsigned short)c[e]) * rs * g[32 + fi0 + e]; o1[e] = y1 * cs.x - y2 * cs.y; o2[e] = y2 * cs.x + y1 * cs.y; }
    r1 = pack8(o1[0], o1[1], o1[2], o1[3], o1[4], o1[5], o1[6], o1[7]); r2 = pack8(o2[0], o2[1], o2[2], o2[3], o2[4], o2[5], o2[6], o2[7]);
}
__device__ __forceinline__ void rope8(bf16x8 a, bf16x8 c, float rs, const float* g, const f32x2* ropep, int fi0, LAS bf16_t* d1, LAS bf16_t* d2) {
    bf16x8 r1, r2; rope8r(a, c, rs, g, ropep, fi0, r1, r2); *(LAS bf16x8*)d1 = r1; *(LAS bf16x8*)d2 = r2;
}
__device__ void attn_pool_phase(LAS unsigned char* lds, const Params& P, int j, int rev) {
    int tid_ = threadIdx.x; asm volatile("" : "+v"(tid_));
    const int tid = tid_, lane = tid & 63, wave = __builtin_amdgcn_readfirstlane(tid >> 6), li = lane & 15, lh = lane >> 4;
    const bf16_t* proj = (const bf16_t*)(P.ws + WS_ACT);
    bf16_t* cat = (bf16_t*)(P.ws + WS_CAT);
    const f32x2* rope = (const f32x2*)(P.ws + WS_ROPE);
    const float* qg = P.qg + j * 64; const float* kg = P.kg + j * 64;
    LAS bf16_t* Ks = (LAS bf16_t*)(lds + ATT_KS_OFF); LAS bf16_t* Vt = (LAS bf16_t*)(lds + ATT_VT_OFF);
    for (int item0 = blockIdx.x; item0 < 512; item0 += gridDim.x) {
        const int item = rev ? 511 - item0 : item0;
        const int b = item >> 4, blk = item & 15; const int tok0 = b * SEQ + blk * 128;
        for (int kh = 0; kh < 2; ++kh) {
            __syncthreads();
            {
                const int key = tid >> 1, p = tid & 1; const int tpos = blk * 128 - 128 + key;
                LAS bf16_t* krow = Ks + key * KS_STRIDE;
                if (tpos >= 0) {
                    const bf16_t* kp = proj + (size_t)(b * SEQ + tpos) * AB_IN + 512 + 64 * kh;
                    const bf16x8 a0 = *(const bf16x8*)(kp + 16 * p), a1 = *(const bf16x8*)(kp + 16 * p + 8), c0 = *(const bf16x8*)(kp + 32 + 16 * p), c1 = *(const bf16x8*)(kp + 32 + 16 * p + 8);
                    float ss = 0.f;
#pragma unroll
                    for (int e = 0; e < 8; ++e) { const float u0 = bf2f((unsigned short)a0[e]), u1 = bf2f((unsigned short)a1[e]), u2 = bf2f((unsigned short)c0[e]), u3 = bf2f((unsigned short)c1[e]); ss += (u0 * u0 + u1 * u1) + (u2 * u2 + u3 * u3); }
                    ss += __shfl_xor(ss, 1);
                    const float rs = __builtin_amdgcn_rsqf(ss * (1.0f / 64.0f) + 1e-6f);
                    rope8(a0, c0, rs, kg, rope + tpos * 32, 16 * p, krow + 16 * p, krow + 32 + 16 * p);
                    asm volatile("" ::: "memory");
                    rope8(a1, c1, rs, kg, rope + tpos * 32, 16 * p + 8, krow + 16 * p + 8, krow + 32 + 16 * p + 8);
                    asm volatile("" ::: "memory");
                    const bf16_t* vp = proj + (size_t)(b * SEQ + tpos) * AB_IN + 640 + 64 * kh + 32 * p;
#pragma unroll
                    for (int q4 = 0; q4 < 4; ++q4) { const bf16x8 vv = *(const bf16x8*)(vp + 8 * q4);
#pragma unroll
                        for (int e = 0; e < 8; ++e) Vt[(32 * p + 8 * q4 + e) * VT_STRIDE + key] = (bf16_t)vv[e];
                        if (q4 & 1) asm volatile("" ::: "memory"); }
                } else {
                    const bf16x8 z = {0, 0, 0, 0, 0, 0, 0, 0};
                    *(LAS bf16x8*)(krow + 16 * p) = z; *(LAS bf16x8*)(krow + 16 * p + 8) = z; *(LAS bf16x8*)(krow + 32 + 16 * p) = z; *(LAS bf16x8*)(krow + 32 + 16 * p + 8) = z;
#pragma unroll
                    for (int e = 0; e < 32; ++e) Vt[(32 * p + e) * VT_STRIDE + key] = 0;
                }
            }
            const int hq = wave & 1, hd = 4 * kh + (wave >> 1);
            __syncthreads();
            const float sink2 = P.sinks[j * 8 + hd] * 1.4426950408889634f;
            for (int qs = 0; qs < 2; ++qs) {
            const int q0 = 64 * hq + 32 * qs;
            bf16x8 Qf[2][2];
#pragma unroll
            for (int m = 0; m < 2; ++m) {
                const int ql = q0 + 16 * m + li; const int tpos = blk * 128 + ql;
                const bf16_t* qp = proj + (size_t)(tok0 + ql) * AB_IN + 64 * hd + 8 * lh;
                const bf16x8 a = *(const bf16x8*)qp, c = *(const bf16x8*)(qp + 32);
                float ss = 0.f;
#pragma unroll
                for (int e = 0; e < 8; ++e) { const float u0 = bf2f((unsigned short)a[e]), u1 = bf2f((unsigned short)c[e]); ss += u0 * u0 + u1 * u1; }
                ss += __shfl_xor(ss, 16); ss += __shfl_xor(ss, 32);
                const float rs = __builtin_amdgcn_rsqf(ss * (1.0f / 64.0f) + 1e-6f) * (0.125f * 1.4426950408889634f);
                rope8r(a, c, rs, qg, rope + tpos * 32, 8 * lh, Qf[m][0], Qf[m][1]);
                asm volatile("" ::: "memory");
            }
            float mrow[2], lrow[2];
            f32x4 ot[4][2];
#pragma unroll
            for (int m = 0; m < 2; ++m) { mrow[m] = sink2; lrow[m] = 1.0f;
#pragma unroll
                for (int dm = 0; dm < 4; ++dm) ot[dm][m] = (f32x4){0.f, 0.f, 0.f, 0.f}; }
            for (int kt = hq; kt < hq + 3; ++kt) {
                if (blk == 0 && kt < 2) continue;
                f32x4 st[4][2];
#pragma unroll
                for (int n = 0; n < 4; ++n) {
                    const LAS bf16_t* kr = Ks + (64 * kt + 16 * n + li) * KS_STRIDE + 8 * lh;
                    const bf16x8 k0 = *(const LAS bf16x8*)kr, k1 = *(const LAS bf16x8*)(kr + 32);
#pragma unroll
                    for (int m = 0; m < 2; ++m) { f32x4 a = (f32x4){0.f, 0.f, 0.f, 0.f}; a = MFMA16(k0, Qf[m][0], a); a = MFMA16(k1, Qf[m][1], a); st[n][m] = a; }
                }
#pragma unroll
                for (int m = 0; m < 2; ++m) {
                    const int r = q0 + 16 * m + li;
                    float mx = -INFINITY;
#pragma unroll
                    for (int n = 0; n < 4; ++n)
#pragma unroll
                        for (int e = 0; e < 4; ++e) { const int c = 64 * kt + 16 * n + 4 * lh + e; const bool ok = (c > r) && (c <= r + 128);
                            const float s = ok ? st[n][m][e] : -INFINITY; st[n][m][e] = s; mx = fmaxf(mx, s); }
                    mx = fmaxf(mx, __shfl_xor(mx, 16)); mx = fmaxf(mx, __shfl_xor(mx, 32));
                    const float mn = fmaxf(mrow[m], mx); const float alpha = __builtin_amdgcn_exp2f(mrow[m] - mn); mrow[m] = mn;
                    float ls = 0.f;
#pragma unroll
                    for (int n = 0; n < 4; ++n)
#pragma unroll
                        for (int e = 0; e < 4; ++e) { const float pv = __builtin_amdgcn_exp2f(st[n][m][e] - mn); st[n][m][e] = pv; ls += pv; }
                    ls += __shfl_xor(ls, 16); ls += __shfl_xor(ls, 32);
                    lrow[m] = lrow[m] * alpha + ls;
#pragma unroll
                    for (int dm = 0; dm < 4; ++dm) ot[dm][m] *= alpha;
                }
#pragma unroll
                for (int ks = 0; ks < 2; ++ks) {
                    bf16x8 Pf[2];
#pragma unroll
                    for (int m = 0; m < 2; ++m) Pf[m] = pack8(st[2 * ks][m][0], st[2 * ks][m][1], st[2 * ks][m][2], st[2 * ks][m][3], st[2 * ks + 1][m][0], st[2 * ks + 1][m][1], st[2 * ks + 1][m][2], st[2 * ks + 1][m][3]);
#pragma unroll
                    for (int dm = 0; dm < 4; ++dm) {
                        const LAS bf16_t* vr = Vt + (16 * dm + li) * VT_STRIDE + 64 * kt + 32 * ks + 4 * lh;
                        const bf16x4 v0 = *(const LAS bf16x4*)vr, v1 = *(const LAS bf16x4*)(vr + 16);
                        const bf16x8 Vf = {v0[0], v0[1], v0[2], v0[3], v1[0], v1[1], v1[2], v1[3]};
#pragma unroll
                        for (int m = 0; m < 2; ++m) ot[dm][m] = MFMA16(Vf, Pf[m], ot[dm][m]);
                    }
                }
            }
#pragma unroll
            for (int m = 0; m < 2; ++m) {
                const float inv = 1.0f / lrow[m]; const int ql = q0 + 16 * m + li;
                bf16_t* op = cat + (size_t)(tok0 + ql) * DM + 64 * hd + 4 * lh;
#pragma unroll
                for (int dm = 0; dm < 4; ++dm) { const f32x4 o = ot[dm][m] * inv; u32x2 w; w.x = cvt_pk_bf16(o[0], o[1]); w.y = cvt_pk_bf16(o[2], o[3]); *(u32x2*)(op + 16 * dm) = w; }
            }
            }
        }
        LAS bf16_t* Us = (LAS bf16_t*)(lds + POOL_US_OFF); LAS bf16_t* Ds = (LAS bf16_t*)(lds + POOL_DS_OFF); LAS bf16_t* Wp = (LAS bf16_t*)(lds + POOL_W_OFF);
        for (int g = 0; g < 4; ++g) {
            const int w = 2 << g;
            __syncthreads();
            for (int ch = tid; ch < 144 * 16; ch += 512) { const int rr = ch >> 4, c8 = (ch & 15) * 8; const int ts = blk * 128 - 16 + rr;
                bf16x8 v = {0, 0, 0, 0, 0, 0, 0, 0};
                if (ts >= 0) v = *(const bf16x8*)(proj + (size_t)(b * SEQ + ts) * AB_IN + 768 + 128 * g + c8);
                *(LAS bf16x8*)(Us + rr * 128 + c8) = v; }
            { const bf16_t* wsrc = (const bf16_t*)(P.ws + WS_POOLW) + (size_t)(j * 4 + g) * 128 * 128;
              for (int ch = tid; ch < 128 * 16; ch += 512) { const int n = ch >> 4, c8 = (ch & 15) * 8; *(LAS bf16x8*)(Wp + n * 136 + c8) = *(const bf16x8*)(wsrc + n * 128 + c8); } }
            __syncthreads();
            { const int c = tid & 127, tq = tid >> 7; const int t0 = tq * 32;
              float s = 0.f;
              for (int jj = 0; jj < w; ++jj) s += bf2f(Us[(16 + t0 - jj) * 128 + c]);
              for (int t = t0; t < t0 + 32; ++t) {
                  const float ut = bf2f(Us[(16 + t) * 128 + c]);
                  const int cnt = min(blk * 128 + t + 1, w);
                  Ds[t * 136 + c] = f2bf(s / (float)cnt - ut);
                  if (t + 1 < t0 + 32) s += bf2f(Us[(16 + t + 1) * 128 + c]) - bf2f(Us[(16 + t + 1 - w) * 128 + c]);
              } }
            __syncthreads();
            {
                f32x4 pa[8];
#pragma unroll
                for (int nf = 0; nf < 8; ++nf) pa[nf] = (f32x4){0.f, 0.f, 0.f, 0.f};
#pragma unroll
                for (int ks = 0; ks < 4; ++ks) {
                    const bf16x8 df = *(const LAS bf16x8*)(Ds + (16 * wave + li) * 136 + 32 * ks + 8 * lh);
#pragma unroll
                    for (int nf = 0; nf < 8; ++nf) { const bf16x8 wf = *(const LAS bf16x8*)(Wp + (16 * nf + li) * 136 + 32 * ks + 8 * lh); pa[nf] = MFMA16(wf, df, pa[nf]); }
                }
                const float* psc = P.pools + j * 512 + 128 * g;
                bf16_t* op = cat + (size_t)(tok0 + 16 * wave + li) * DM + 512 + 128 * g + 4 * lh;
#pragma unroll
                for (int nf = 0; nf < 8; ++nf) { const f32x4 sc = *(const f32x4*)(psc + 16 * nf + 4 * lh); const f32x4 o = pa[nf] * sc;
                    u32x2 wv; wv.x = cvt_pk_bf16(o[0], o[1]); wv.y = cvt_pk_bf16(o[2], o[3]); *(u32x2*)(op + 16 * nf) = wv; }
            }
        }
    }
    __syncthreads();
}

constexpr int HG_A1 = 0, HG_AP = 8704, HG_BP = 17408, HG_KDT = 26112, HG_VT = 36352, HG_ST = 46592, HG_SC = 81408, HG_TOT = 83968, HG_RED = 86016;

#define HG_BAR() do { asm volatile("s_waitcnt lgkmcnt(0)" ::: "memory"); __builtin_amdgcn_s_barrier(); asm volatile("" ::: "memory"); } while (0)
__device__ void hgrn_phase(LAS unsigned char* lds, const Params& P, int j, int rev) {
    int tid_ = threadIdx.x; asm volatile("" : "+v"(tid_));
    const int tid = tid_, lane = tid & 63, wave = __builtin_amdgcn_readfirstlane(tid >> 6), li = lane & 15, lh = lane >> 4;
    const bf16_t* proj = (const bf16_t*)(P.ws + WS_ACT);
    bf16_t* cat = (bf16_t*)(P.ws + WS_CAT);
    LAS bf16_t* A1s = (LAS bf16_t*)(lds + HG_A1); LAS bf16_t* Aps = (LAS bf16_t*)(lds + HG_AP); LAS bf16_t* Bps = (LAS bf16_t*)(lds + HG_BP);
    LAS bf16_t* KdT = (LAS bf16_t*)(lds + HG_KDT); LAS bf16_t* VT = (LAS bf16_t*)(lds + HG_VT); LAS bf16_t* St = (LAS bf16_t*)(lds + HG_ST);
    LAS bf16_t* Sc = (LAS bf16_t*)(lds + HG_SC); LAS float* tot = (LAS float*)(lds + HG_TOT); LAS float* red = (LAS float*)(lds + HG_RED);
    const int kc = tid & 127, tg = tid >> 7;
    for (int item0 = blockIdx.x; item0 < 256; item0 += gridDim.x) {
        const int item = rev ? 255 - item0 : item0;
        const int b = item >> 3, h = item & 7;
        const float lb = ((const float*)(P.ws + WS_LB))[j * 1024 + h * 128 + kc];
        f32x4 og4 = *(const f32x4*)(P.cog + j * 128 + 16 * wave + 4 * lh);
        __syncthreads();
        for (int i = tid; i < 128 * 136 / 2; i += 512) ((LAS unsigned*)St)[i] = 0u;
        f32x4 Sacc[8];
#pragma unroll
        for (int vf = 0; vf < 8; ++vf) Sacc[vf] = (f32x4){0.f, 0.f, 0.f, 0.f};
        unsigned short rq[8], rf[8], ri[8];
        { const bf16_t* p0 = proj + (size_t)(b * SEQ + 8 * tg) * HG_IN + h * 128 + kc;
#pragma unroll
          for (int e = 0; e < 8; ++e) { rq[e] = p0[(size_t)e * HG_IN]; rf[e] = p0[(size_t)e * HG_IN + 1024]; ri[e] = p0[(size_t)e * HG_IN + 2048]; } }
        for (int c = 0; c < 64; ++c) {
            const size_t crow = (size_t)(b * SEQ + 32 * c);
            float cs[8], kk[8], qt[8];
            { float run = 0.f;
#pragma unroll
              for (int e = 0; e < 8; ++e) { const float z = bf2f(rf[e]); const float sg = fast_sigmoid(z); const float f = lb + (1.0f - lb) * sg;
                  run += __logf(fmaxf(f, 1e-6f)); cs[e] = run; kk[e] = 1.0f - f; const float qv = bf2f(rq[e]); qt[e] = qv * fast_sigmoid(qv); }
              tot[tg * 128 + kc] = run; }
            bf16x4 gt[2];
#pragma unroll
            for (int m = 0; m < 2; ++m) gt[m] = *(const bf16x4*)(proj + (crow + 16 * m + li) * HG_IN + 3072 + h * 128 + 16 * wave + 4 * lh);
            HG_BAR();
            { const float t0 = tot[kc], t1 = tot[128 + kc], t2 = tot[256 + kc], t3 = tot[384 + kc];
              const float pre = (tg > 0 ? t0 : 0.f) + (tg > 1 ? t1 : 0.f) + (tg > 2 ? t2 : 0.f);
              const float gm = t0 + t1, gl = gm + t2 + t3;
              float kd[8], vv[8];
#pragma unroll
              for (int e = 0; e < 8; ++e) { const float G = pre + cs[e]; const int t = 8 * tg + e;
                  A1s[t * 136 + kc] = f2bf(qt[e] * fast_exp(G)); Aps[t * 136 + kc] = f2bf(qt[e] * fast_exp(G - gm)); Bps[t * 136 + kc] = f2bf(kk[e] * fast_exp(gm - G));
                  kd[e] = kk[e] * fast_exp(gl - G); vv[e] = bf2f(ri[e]); }
              *(LAS bf16x8*)(KdT + kc * 40 + 8 * tg) = pack8(kd[0], kd[1], kd[2], kd[3], kd[4], kd[5], kd[6], kd[7]);
              *(LAS bf16x8*)(VT + kc * 40 + 8 * tg) = pack8(vv[0], vv[1], vv[2], vv[3], vv[4], vv[5], vv[6], vv[7]); }
            if (c + 1 < 64) { const bf16_t* p0 = proj + (crow + 32 + 8 * tg) * HG_IN + h * 128 + kc;
#pragma unroll
              for (int e = 0; e < 8; ++e) { rq[e] = p0[(size_t)e * HG_IN]; rf[e] = p0[(size_t)e * HG_IN + 1024]; ri[e] = p0[(size_t)e * HG_IN + 2048]; } }
            HG_BAR();
            float dec[4];
#pragma unroll
            for (int e = 0; e < 4; ++e) { const int k = 16 * wave + 4 * lh + e; dec[e] = fast_exp(tot[k] + tot[128 + k] + tot[256 + k] + tot[384 + k]); }
            f32x4 oacc[2] = {(f32x4){0.f, 0.f, 0.f, 0.f}, (f32x4){0.f, 0.f, 0.f, 0.f}};
#pragma unroll
            for (int ks = 0; ks < 4; ++ks) {
                const bf16x8 sf = *(const LAS bf16x8*)(St + (16 * wave + li) * 136 + 32 * ks + 8 * lh);
#pragma unroll
                for (int m = 0; m < 2; ++m) { const bf16x8 af = *(const LAS bf16x8*)(A1s + (16 * m + li) * 136 + 32 * ks + 8 * lh); oacc[m] = MFMA16(sf, af, oacc[m]); }
            }
            if (wave < 3) {
                const int sfr = (wave == 2) ? 1 : 0, tfr = (wave == 0) ? 0 : 1;
                f32x4 sa = (f32x4){0.f, 0.f, 0.f, 0.f};
#pragma unroll
                for (int ks = 0; ks < 4; ++ks) { const bf16x8 bf = *(const LAS bf16x8*)(Bps + (16 * sfr + li) * 136 + 32 * ks + 8 * lh); const bf16x8 af = *(const LAS bf16x8*)(Aps + (16 * tfr + li) * 136 + 32 * ks + 8 * lh); sa = MFMA16(bf, af, sa); }
                const int t = 16 * tfr + li;
                float sv[4];
#pragma unroll
                for (int e = 0; e < 4; ++e) { const int s = 16 * sfr + 4 * lh + e; sv[e] = (s <= t) ? sa[e] : 0.f; }
                u32x2 w; w.x = cvt_pk_bf16(sv[0], sv[1]); w.y = cvt_pk_bf16(sv[2], sv[3]); *(LAS u32x2*)(Sc + t * 40 + 16 * sfr + 4 * lh) = w;
            } else if (wave == 3) { u32x2 w; w.x = 0u; w.y = 0u; *(LAS u32x2*)(Sc + li * 40 + 16 + 4 * lh) = w; }
            HG_BAR();
            { const bf16x8 vf = *(const LAS bf16x8*)(VT + (16 * wave + li) * 40 + 8 * lh);
#pragma unroll
              for (int m = 0; m < 2; ++m) { const bf16x8 sf = *(const LAS bf16x8*)(Sc + (16 * m + li) * 40 + 8 * lh); oacc[m] = MFMA16(vf, sf, oacc[m]); } }
#pragma unroll
            for (int m = 0; m < 2; ++m) { float ss = 0.f;
#pragma unroll
                for (int e = 0; e < 4; ++e) { const float o = oacc[m][e] * fast_sigmoid(bf2f((unsigned short)gt[m][e])); oacc[m][e] = o; ss += o * o; }
                ss += __shfl_xor(ss, 16); ss += __shfl_xor(ss, 32);
                if (lh == 0) red[wave * 32 + 16 * m + li] = ss; }
            HG_BAR();
#pragma unroll
            for (int m = 0; m < 2; ++m) { const int t = 16 * m + li; float ss = 0.f;
#pragma unroll
                for (int w8 = 0; w8 < 8; ++w8) ss += red[w8 * 32 + t];
                const float rs = __builtin_amdgcn_rsqf(ss * (1.0f / 128.0f) + 1e-6f);
                const f32x4 o = oacc[m] * rs * og4; u32x2 w; w.x = cvt_pk_bf16(o[0], o[1]); w.y = cvt_pk_bf16(o[2], o[3]);
                *(u32x2*)(cat + (crow + t) * DM + h * 128 + 16 * wave + 4 * lh) = w; }
            { const bf16x8 kf = *(const LAS bf16x8*)(KdT + (16 * wave + li) * 40 + 8 * lh);
#pragma unroll
              for (int vf = 0; vf < 8; ++vf) { const bf16x8 vfr = *(const LAS bf16x8*)(VT + (16 * vf + li) * 40 + 8 * lh);
                  f32x4 s = Sacc[vf]; s[0] *= dec[0]; s[1] *= dec[1]; s[2] *= dec[2]; s[3] *= dec[3];
                  s = MFMA16(kf, vfr, s); Sacc[vf] = s;
                  u32x2 w; w.x = cvt_pk_bf16(s[0], s[1]); w.y = cvt_pk_bf16(s[2], s[3]); *(LAS u32x2*)(St + (16 * vf + li) * 136 + 16 * wave + 4 * lh) = w; } }
        }
    }
    __syncthreads();
}


__device__ __forceinline__ void grid_barrier(unsigned* bar, unsigned k) {
    asm volatile("s_waitcnt vmcnt(0)" ::: "memory");
    __syncthreads();
    if (threadIdx.x == 0) {
        const unsigned ngrp = 8u, gsz = gridDim.x / ngrp, g = blockIdx.x % ngrp;
        __builtin_amdgcn_fence(__ATOMIC_RELEASE, "agent");
        asm volatile("s_waitcnt vmcnt(0)" ::: "memory");
        const unsigned old = __hip_atomic_fetch_add(bar + 64 * g, 1u, __ATOMIC_RELAXED, __HIP_MEMORY_SCOPE_AGENT);
        if (old + 1u == gsz * k) __hip_atomic_fetch_add(bar + 64 * ngrp, 1u, __ATOMIC_RELAXED, __HIP_MEMORY_SCOPE_AGENT);
        while (__hip_atomic_load(bar + 64 * ngrp, __ATOMIC_RELAXED, __HIP_MEMORY_SCOPE_AGENT) < ngrp * k) __builtin_amdgcn_s_sleep(1);
        __builtin_amdgcn_fence(__ATOMIC_ACQUIRE, "agent");
        asm volatile("s_waitcnt vmcnt(0)" ::: "memory");
    }
    __syncthreads();
}
__global__ void __launch_bounds__(512, 2) mega(Params P) {
    extern __shared__ __attribute__((aligned(16))) unsigned char lds_raw[];
    LAS unsigned char* lds = (LAS unsigned char*)lds_raw;
    cg::grid_group grid = cg::this_grid();
    unsigned char* ws = P.ws;
    bf16_t* xb = (bf16_t*)(ws + WS_XB); bf16_t* act = (bf16_t*)(ws + WS_ACT); bf16_t* cat = (bf16_t*)(ws + WS_CAT); unsigned* rowss = (unsigned*)(ws + WS_ROWSS);
    for (int p = P.lo; p < P.hi; ++p) {
        const bf16_t* xhA = (const bf16_t*)((p > NPHASE_K - 3) ? (ws + WS_ACT + 384 * MiB) : (unsigned char*)P.out);
        if (p > P.lo) { if (P.hi > 1000000) grid.sync(); else grid_barrier((unsigned*)(ws + WS_BAR), (unsigned)(p - P.lo)); }
        if (p == 0) { phase0(lds, P); continue; }
        const int q = p - 1, layer = q / 7, step = q % 7, jj = layer >> 1; const bool even = (layer & 1) == 0;
        pg8::StaticOrder S;
        if (step == 0 || step == 5) {
            const int s = step == 0 ? 0 : 1;
            pg8::Gemm g{xhA, (const bf16_t*)(ws + WS_WGU) + (size_t)(layer * 2 + s) * 2 * DFF * DM, MTOK, 2 * DFF, DM}; S.init(MTOK, 2 * DFF, gridDim.x, blockIdx.x, p & 1);
            EpiSwiglu E{act, rowss + (size_t)(layer * 3 + (s ? 2 : 0)) * MTOK};
            pg8::gemm_phase<EpiSwiglu, true>(lds, g, S, E);
        } else if (step == 2) {
            const int N = even ? AB_IN : HG_IN;
            const bf16_t* W = even ? (const bf16_t*)(ws + WS_WABIN) + (size_t)jj * DM * AB_IN : (const bf16_t*)(ws + WS_WCIN) + (size_t)jj * DM * HG_IN;
            pg8::Gemm g{xhA, W, MTOK, N, DM}; S.init(MTOK, N, gridDim.x, blockIdx.x, p & 1);
            EpiProj E{act, N, rowss + (size_t)(layer * 3 + 1) * MTOK};
            pg8::gemm_phase<EpiProj, true>(lds, g, S, E);
        } else if (step == 3) {
            for (int rep = 0; rep < REP_MIX; ++rep) { if (even) attn_pool_phase(lds, P, jj, p & 1); else hgrn_phase(lds, P, jj, p & 1); }
        } else {
            const bf16_t* A; const bf16_t* W; int K; float scale; int nid;
            if (step == 4) { A = cat; W = even ? (const bf16_t*)(ws + WS_WABOUT) + (size_t)jj * DM * DM : (const bf16_t*)(ws + WS_WCOUT) + (size_t)jj * DM * DM; K = DM; scale = 1.0f; nid = layer * 3 + 2; }
            else { const int s = step == 1 ? 0 : 1; A = act; W = (const bf16_t*)(ws + WS_WDN) + (size_t)(layer * 2 + s) * DFF * DM; K = DFF; scale = 0.5f; nid = s ? (layer + 1) * 3 : layer * 3 + 1; }
            pg8::Gemm g{A, W, MTOK, DM, K}; S.init(MTOK, DM, gridDim.x, blockIdx.x, p & 1);
            _Float16* xh_main = (_Float16*)P.out; _Float16* xh_alt = (_Float16*)(ws + WS_ACT + 384 * MiB);
            if (p == NPHASE_K - 1) { EpiResid<true> E{xh_alt, nullptr, P.out, nullptr, nullptr, scale, lds}; pg8::gemm_phase<EpiResid<true>>(lds, g, S, E); }
            else { EpiResid<false> E{xh_main, (p == NPHASE_K - 3) ? xh_alt : xh_main, nullptr, xb, rowss + (size_t)nid * MTOK, scale, lds}; pg8::gemm_phase<EpiResid<false>>(lds, g, S, E); }
        }
    }
}

constexpr int NPHASE = 29;
#ifndef NRUN
#define NRUN 29
#endif

extern "C" void kernel_launch(void* const* d_in, const int* in_sizes, int n_in, void* d_out, int out_size, void* d_ws, size_t ws_size, hipStream_t stream) {
    static int grid = 0;
    if (grid == 0) {
        if (n_in != 17 || out_size != MTOK * DM || ws_size < WS_END) { fprintf(stderr, "kernel_launch: unexpected shapes (n_in %d out %d ws %zu)\n", n_in, out_size, ws_size); grid = -1; return; }
        int dev = 0, cus = 0, per_cu = 0;
        hipGetDevice(&dev); hipDeviceGetAttribute(&cus, hipDeviceAttributeMultiprocessorCount, dev);
        if (hipFuncSetAttribute((const void*)mega, hipFuncAttributeMaxDynamicSharedMemorySize, LDS_BYTES) != hipSuccess) { fprintf(stderr, "kernel_launch: hipFuncSetAttribute failed\n"); grid = -1; return; }
        if (hipOccupancyMaxActiveBlocksPerMultiprocessor(&per_cu, (const void*)mega, 512, LDS_BYTES) != hipSuccess || per_cu < 1) { fprintf(stderr, "kernel_launch: occupancy query says %d\n", per_cu); per_cu = 1; }
        (void)hipGetLastError();
        grid = cus;
    }
    if (grid < 0) return;
    Params p{};
    p.x = (const float*)d_in[0]; p.pos = (const int*)d_in[1]; p.ng = (const float*)d_in[2]; p.wg = (const float*)d_in[3]; p.wu = (const float*)d_in[4]; p.wd = (const float*)d_in[5];
    p.abin = (const float*)d_in[6]; p.about = (const float*)d_in[7]; p.qg = (const float*)d_in[8]; p.kg = (const float*)d_in[9]; p.sinks = (const float*)d_in[10];
    p.poolw = (const float*)d_in[11]; p.pools = (const float*)d_in[12]; p.cin = (const float*)d_in[13]; p.cout = (const float*)d_in[14]; p.cog = (const float*)d_in[15]; p.lbl = (const float*)d_in[16];
    p.out = (float*)d_out; p.ws = (unsigned char*)d_ws;
#if ONE_LAUNCH
    p.lo = 0; p.hi = NPHASE;
    (void)hipMemsetAsync((unsigned char*)d_ws + WS_BAR, 0, 9 * 256, stream);
    void* args[] = {&p};
    hipError_t e = hipLaunchCooperativeKernel((const void*)mega, dim3(grid), dim3(512), args, LDS_BYTES, stream);
    if (e != hipSuccess) fprintf(stderr, "cooperative launch failed: %s (grid %d)\n", hipGetErrorString(e), grid);
#else
    for (int ph = 0; ph < NRUN; ++ph) { p.lo = ph; p.hi = ph + 1; hipLaunchKernelGGL(mega, dim3(grid), dim3(512), LDS_BYTES, stream, p); }
#endif
}
```

```cpp
#include <hip/hip_runtime.h>
#include <hip/hip_cooperative_groups.h>
#include <cstdio>
namespace cg = cooperative_groups;

#ifndef REP_MIX
#define REP_MIX 1
#endif
#ifndef STREAM_BF16
#define STREAM_BF16 1
#endif
#ifndef ONE_LAUNCH
#define ONE_LAUNCH 1
#endif

#define LAS __attribute__((address_space(3)))
typedef unsigned short bf16_t;
typedef short bf16x8 __attribute__((ext_vector_type(8)));
typedef short bf16x4 __attribute__((ext_vector_type(4)));
typedef float f32x4 __attribute__((ext_vector_type(4)));
typedef float f32x2 __attribute__((ext_vector_type(2)));
typedef unsigned u32x4 __attribute__((ext_vector_type(4)));
typedef unsigned u32x2 __attribute__((ext_vector_type(2)));
typedef _Float16 f16x2_t __attribute__((ext_vector_type(2)));
typedef _Float16 f16x4_t __attribute__((ext_vector_type(4)));
typedef _Float16 f16x8_t __attribute__((ext_vector_type(8)));

constexpr int MTOK = 65536, DM = 1024, DFF = 2816, SEQ = 2048, NB = 32;
constexpr int AB_IN = 1280, HG_IN = 4096;
constexpr int LDS_BYTES = 131072 + 4096 + 2048;

constexpr size_t MiB = 1024ull * 1024ull;
constexpr size_t WS_XB = 0;
constexpr size_t WS_ACT = 128 * MiB;
constexpr size_t WS_CAT = 640 * MiB;
constexpr size_t WS_WGU = 768 * MiB;
constexpr size_t WS_WDN = 856 * MiB;
constexpr size_t WS_WABIN = 900 * MiB;
constexpr size_t WS_WABOUT = 905 * MiB;
constexpr size_t WS_WCIN = 909 * MiB;
constexpr size_t WS_WCOUT = 925 * MiB;
constexpr size_t WS_POOLW = 929 * MiB;
constexpr size_t WS_ROWSS = 930 * MiB;
constexpr size_t WS_ROPE = 938 * MiB;
constexpr size_t WS_LB = 939 * MiB;
constexpr size_t WS_BAR = 940 * MiB;
constexpr size_t WS_END = 941 * MiB;

constexpr int NPHASE_K = 29;
struct Params {
    const float* x; const int* pos; const float* ng; const float* wg; const float* wu; const float* wd;
    const float* abin; const float* about; const float* qg; const float* kg; const float* sinks; const float* poolw; const float* pools;
    const float* cin; const float* cout; const float* cog; const float* lbl;
    float* out; unsigned char* ws; int lo, hi;
};

__device__ __forceinline__ float bf2f(unsigned short b) { return __uint_as_float(((unsigned)b) << 16); }
typedef __bf16 bf16x2_t __attribute__((ext_vector_type(2)));
__device__ __forceinline__ unsigned cvt_pk_bf16(float lo, float hi) { f32x2 v = {lo, hi}; bf16x2_t r = __builtin_convertvector(v, bf16x2_t); return __builtin_bit_cast(unsigned, r); }
__device__ __forceinline__ unsigned cvt_pk_f16(float lo, float hi) { f32x2 v = {lo, hi}; f16x2_t r = __builtin_convertvector(v, f16x2_t); return __builtin_bit_cast(unsigned, r); }
__device__ __forceinline__ bf16_t f2bf(float f) { return (bf16_t)(cvt_pk_bf16(f, 0.f) & 0xffffu); }
__device__ __forceinline__ bf16x8 pack8(float a0, float a1, float a2, float a3, float a4, float a5, float a6, float a7) {
    u32x4 w; w.x = cvt_pk_bf16(a0, a1); w.y = cvt_pk_bf16(a2, a3); w.z = cvt_pk_bf16(a4, a5); w.w = cvt_pk_bf16(a6, a7); return __builtin_bit_cast(bf16x8, w); }
__device__ __forceinline__ float fast_exp(float x) { return __builtin_amdgcn_exp2f(x * 1.4426950408889634f); }
__device__ __forceinline__ float fast_sigmoid(float x) { return __builtin_amdgcn_rcpf(1.0f + fast_exp(-x)); }
#define MFMA16(a, b, c) __builtin_amdgcn_mfma_f32_16x16x32_bf16((a), (b), (c), 0, 0, 0)

namespace pg8 {
constexpr int BM = 256, BK = 64, HALF = 128, HTB = HALF * BK * 2, STAGE_BYTES = 8 * HTB, NXCD = 8, WGM = 8;
__device__ __forceinline__ int lds_byte(int r, int c) { const int st = (r >> 4) * 2 + (c >> 5), rr = r & 15, cc = c & 31, ob = rr * 64 + cc * 2; return st * 1024 + (ob ^ (((ob >> 9) & 1) << 5)); }
__device__ __forceinline__ void stage_rc(int b, int& R, int& C) { const int st = b / 1024, sb = b % 1024, swz = sb ^ (((sb >> 9) & 1) << 5); R = (st >> 1) * 16 + swz / 64; C = (st & 1) * 32 + (swz % 64) / 2; }
__device__ __forceinline__ int perm32(int rho) { const int n = rho >> 4, i = rho & 15; return 8 * (i >> 2) + 4 * n + (i & 3); }
struct Unit { int pm, pn; };
struct Gemm { const bf16_t* A; const bf16_t* Bt; int M, N, K; };
struct StaticOrder {
    int nM, nN, nwg, G, c, rev;
    __device__ void init(int M, int N, int G_, int c_, int rev_ = 0) { nM = M / BM; nN = N / BM; nwg = nM * nN; G = G_; c = c_; rev = rev_; }
    __device__ bool next(int i, Unit& u) const {
        long L = (long)i * G + c; if (L >= nwg) return false;
        if (rev) L = nwg - 1 - L;
        int wgid = (int)L; { const int q = nwg / NXCD, r = nwg % NXCD, xcd = wgid % NXCD, off = wgid / NXCD; wgid = (xcd < r ? xcd * (q + 1) : r * (q + 1) + (xcd - r) * q) + off; }
        const int nig = WGM * nN, gid = wgid / nig, fm = gid * WGM, gsz = (nM - fm) < WGM ? (nM - fm) : WGM;
        u.pm = fm + ((wgid % nig) % gsz); u.pn = (wgid % nig) / gsz; return true;
    }
};

template <class Epi, bool F16 = false>
__device__ __forceinline__ void gemm_phase(LAS unsigned char* lds, const Gemm g, const StaticOrder& S, const Epi& E) {
    int tid_ = threadIdx.x; asm volatile("" : "+v"(tid_));
    const int tid = tid_, wid = __builtin_amdgcn_readfirstlane(tid >> 6), lane = tid & 63, wr = wid >> 2, wc = wid & 3, fr = lane & 15, fq = lane >> 4;
    const int K = g.K, nt = K / BK;
    unsigned voffA[2], voffB[2];
#pragma unroll
    for (int i = 0; i < 2; ++i) { int R, C; stage_rc(tid * 16 + i * 8192, R, C); const int Rb = Epi::PERM ? ((R & ~31) + perm32(R & 31)) : R;
        voffA[i] = (unsigned)(R * K + C) * 2u; voffB[i] = (unsigned)(Rb * K + C) * 2u; }
    const long kstep = (long)(BK * 2);
    const size_t hstep = (size_t)HALF * K * 2;
    const size_t tstep = 2 * hstep;
    const unsigned ldsw = (unsigned)wid * 1024u;
    const int aoff = lds_byte(wr * 64 + fr, fq * 8), boff = lds_byte(wc * 32 + fr, fq * 8);
#define PG8_SA(b, h) (((b) * 2 + (h)) * HTB)
#define PG8_SB(b, h) ((4 + (b) * 2 + (h)) * HTB)
#define PG8_STAGE(bufoff, gbase, voff) do { _Pragma("unroll") for (int _i = 0; _i < 2; ++_i) \
        __builtin_amdgcn_global_load_lds((const unsigned*)((const char*)(gbase) + (voff)[_i]), (LAS unsigned*)(lds + (bufoff) + ldsw + _i * 8192), 16, 0, 0); } while (0)
#define PG8_LDA(dst, b, h) do { _Pragma("unroll") for (int m = 0; m < 4; ++m) _Pragma("unroll") for (int k = 0; k < 2; ++k) dst[m][k] = *(const LAS bf16x8*)(lds + PG8_SA(b, h) + aoff + m * 2048 + k * 1024); } while (0)
#define PG8_LDB(dst, b, h) do { _Pragma("unroll") for (int n = 0; n < 2; ++n) _Pragma("unroll") for (int k = 0; k < 2; ++k) dst[n][k] = *(const LAS bf16x8*)(lds + PG8_SB(b, h) + boff + n * 2048 + k * 1024); } while (0)
#define PG8_MMA(ai, bj, At, Bt) do { __builtin_amdgcn_s_setprio(1); _Pragma("unroll") for (int m = 0; m < 4; ++m) _Pragma("unroll") for (int n = 0; n < 2; ++n) _Pragma("unroll") for (int k = 0; k < 2; ++k) \
        acc[ai][bj][m][n] = F16 ? __builtin_amdgcn_mfma_f32_16x16x32_f16(__builtin_bit_cast(f16x8_t, Bt[n][k]), __builtin_bit_cast(f16x8_t, At[m][k]), acc[ai][bj][m][n], 0, 0, 0) \
                                : __builtin_amdgcn_mfma_f32_16x16x32_bf16(Bt[n][k], At[m][k], acc[ai][bj][m][n], 0, 0, 0); __builtin_amdgcn_s_setprio(0); } while (0)
#define PG8_WAIT_V(n) asm volatile("s_waitcnt vmcnt(" #n ")" ::: "memory")
#define PG8_WAIT_L(n) asm volatile("s_waitcnt lgkmcnt(" #n ")" ::: "memory")
#define PG8_BAR __builtin_amdgcn_s_barrier()
#define PG8_SCHED __builtin_amdgcn_sched_barrier(0)
    Unit cur, nxt; int ui = 0;
    if (!S.next(0, cur)) return;
    f32x4 acc[2][2][4][2];
#pragma unroll
    for (int a = 0; a < 2; ++a)
#pragma unroll
        for (int b = 0; b < 2; ++b)
#pragma unroll
            for (int m = 0; m < 4; ++m)
#pragma unroll
                for (int n = 0; n < 2; ++n) acc[a][b][m][n] = (f32x4){0.f, 0.f, 0.f, 0.f};
    bf16x8 At[4][2], B0[2][2], B1[2][2];
    typename Epi::Pre pre; LAS unsigned char* const pretab = lds + 131072 + 4096;
    E.prefetch_lds(pretab, cur, wid, lane);
    const char* cA = (const char*)g.A + (size_t)cur.pm * tstep; const char* cB = (const char*)g.Bt + (size_t)cur.pn * tstep;
    int ck = (int)kstep;
    PG8_STAGE(PG8_SB(0, 0), cB, voffB); PG8_STAGE(PG8_SA(0, 0), cA, voffA); PG8_STAGE(PG8_SB(0, 1), cB + hstep, voffB); PG8_STAGE(PG8_SA(0, 1), cA + hstep, voffA);
    if (wr == 1) PG8_BAR;
    PG8_WAIT_V(4); PG8_BAR;
    PG8_STAGE(PG8_SB(1, 0), cB + kstep, voffB); PG8_STAGE(PG8_SA(1, 0), cA + kstep, voffA); PG8_STAGE(PG8_SB(1, 1), cB + hstep + kstep, voffB);
    PG8_WAIT_V(6); PG8_BAR;
    for (;;) {
        const bool has_next = S.next(ui + 1, nxt);
        const int nk = has_next ? -ck : ck; const int nofs = (has_next && nk < 0) ? (nt - 1) * (int)kstep : 0;
        const char* nA = has_next ? (const char*)g.A + (size_t)nxt.pm * tstep + nofs : cA; const char* nB = has_next ? (const char*)g.Bt + (size_t)nxt.pn * tstep + nofs : cB;
        for (int t = 0; t < nt; t += 2) {
            const bool last = (t == nt - 2);
            const char* a1 = cA + (t + 1) * ck;
            const char* a2 = last ? nA : cA + (t + 2) * ck; const char* b2 = last ? nB : cB + (t + 2) * ck;
            const int k3 = last ? nk : ck; const char* a3 = a2 + k3; const char* b3 = b2 + k3;
            PG8_LDB(B0, 0, 0); PG8_SCHED; PG8_LDA(At, 0, 0); PG8_STAGE(PG8_SA(1, 1), a1 + hstep, voffA);
            PG8_WAIT_L(8); PG8_BAR; PG8_WAIT_L(0); PG8_MMA(0, 0, At, B0); PG8_BAR; PG8_SCHED;
            PG8_LDB(B1, 0, 1); PG8_STAGE(PG8_SB(0, 0), b2, voffB);
            PG8_BAR; PG8_WAIT_L(0); PG8_MMA(0, 1, At, B1); PG8_BAR;
            PG8_LDA(At, 0, 1); PG8_STAGE(PG8_SA(0, 0), a2, voffA);
            PG8_BAR; PG8_WAIT_L(0); PG8_MMA(1, 0, At, B0); PG8_BAR; PG8_SCHED;
            PG8_STAGE(PG8_SB(0, 1), b2 + hstep, voffB);
            PG8_WAIT_V(6); PG8_BAR; PG8_MMA(1, 1, At, B1); PG8_BAR;
            PG8_LDB(B0, 1, 0); PG8_SCHED; PG8_LDA(At, 1, 0); PG8_STAGE(PG8_SA(0, 1), a2 + hstep, voffA);
            PG8_WAIT_L(8); PG8_BAR; PG8_WAIT_L(0); PG8_MMA(0, 0, At, B0); PG8_BAR; PG8_SCHED;
            PG8_LDB(B1, 1, 1); PG8_STAGE(PG8_SB(1, 0), b3, voffB);
            PG8_BAR; PG8_WAIT_L(0); PG8_MMA(0, 1, At, B1); PG8_BAR;
            PG8_LDA(At, 1, 1); PG8_STAGE(PG8_SA(1, 0), a3, voffA);
            PG8_BAR; PG8_WAIT_L(0); PG8_MMA(1, 0, At, B0); PG8_BAR; PG8_SCHED;
            PG8_STAGE(PG8_SB(1, 1), b3 + hstep, voffB);
            PG8_WAIT_V(6); PG8_BAR; PG8_MMA(1, 1, At, B1); PG8_BAR;
        }
        E.fetch_pre(pre, pretab + (ui & 1) * 1024, wr, fr);
        E(acc, pre, cur, wr, wc, fr, fq);
        if (!has_next) break;
        E.prefetch_lds(pretab + ((ui + 1) & 1) * 1024, nxt, wid, lane);
#pragma unroll
        for (int a = 0; a < 2; ++a)
#pragma unroll
            for (int b = 0; b < 2; ++b)
#pragma unroll
                for (int m = 0; m < 4; ++m)
#pragma unroll
                    for (int n = 0; n < 2; ++n) acc[a][b][m][n] = (f32x4){0.f, 0.f, 0.f, 0.f};
        cur = nxt; cA = nA; cB = nB; ck = nk; ++ui;
    }
    PG8_WAIT_V(0);
    if (wr == 0) PG8_BAR;
    PG8_BAR;
#undef PG8_SA
#undef PG8_SB
#undef PG8_STAGE
#undef PG8_LDA
#undef PG8_LDB
#undef PG8_MMA
#undef PG8_WAIT_V
#undef PG8_WAIT_L
#undef PG8_BAR
#undef PG8_SCHED
}
}

struct EpiSwiglu {
    static constexpr bool PERM = true;
    bf16_t* O; const unsigned* rowss;
    struct Pre { unsigned v[8]; };
    static constexpr bool LDS_PRE = true;
    __device__ __forceinline__ void prefetch_lds(LAS unsigned char* tab, const pg8::Unit& u, int wid, int lane) const {
        if (wid < 4) __builtin_amdgcn_global_load_lds((const unsigned*)(rowss + u.pm * 256 + wid * 64 + lane), (LAS unsigned*)(tab + wid * 256), 4, 0, 0); }
    __device__ __forceinline__ void fetch_pre(Pre& pre, const LAS unsigned char* tab, int wr, int fr) const {
#pragma unroll
        for (int i = 0; i < 8; ++i) pre.v[i] = ((const LAS unsigned*)tab)[(i >> 2) * 128 + wr * 64 + (i & 3) * 16 + fr]; }
    __device__ __forceinline__ void operator()(const f32x4 (&acc)[2][2][4][2], const Pre& pre, const pg8::Unit& u, int wr, int wc, int fr, int fq) const {
        const int row0 = u.pm * 256 + wr * 64 + fr, h0 = u.pn * 128 + wc * 32 + 8 * fq;
#pragma unroll
        for (int ai = 0; ai < 2; ++ai)
#pragma unroll
            for (int m = 0; m < 4; ++m) {
                const int r = row0 + ai * 128 + m * 16;
                const float rs = __builtin_amdgcn_rsqf((float)pre.v[ai * 4 + m] * (1.0f / (1024.0f * 1024.0f)) + 1e-6f);
                float o[8];
#pragma unroll
                for (int n = 0; n < 2; ++n)
#pragma unroll
                    for (int j = 0; j < 4; ++j) { const float gv = acc[ai][0][m][n][j] * rs, uv = acc[ai][1][m][n][j] * rs; o[n * 4 + j] = gv * uv * fast_sigmoid(gv); }
                u32x4 w; w.x = cvt_pk_bf16(o[0], o[1]); w.y = cvt_pk_bf16(o[2], o[3]); w.z = cvt_pk_bf16(o[4], o[5]); w.w = cvt_pk_bf16(o[6], o[7]);
                *(u32x4*)(O + (size_t)r * DFF + h0) = w;
            }
    }
};
struct EpiProj {
    static constexpr bool PERM = true;
    bf16_t* O; int ldc; const unsigned* rowss;
    struct Pre { unsigned v[8]; };
    static constexpr bool LDS_PRE = true;
    __device__ __forceinline__ void prefetch_lds(LAS unsigned char* tab, const pg8::Unit& u, int wid, int lane) const {
        if (wid < 4) __builtin_amdgcn_global_load_lds((const unsigned*)(rowss + u.pm * 256 + wid * 64 + lane), (LAS unsigned*)(tab + wid * 256), 4, 0, 0); }
    __device__ __forceinline__ void fetch_pre(Pre& pre, const LAS unsigned char* tab, int wr, int fr) const {
#pragma unroll
        for (int i = 0; i < 8; ++i) pre.v[i] = ((const LAS unsigned*)tab)[(i >> 2) * 128 + wr * 64 + (i & 3) * 16 + fr]; }
    __device__ __forceinline__ void operator()(const f32x4 (&acc)[2][2][4][2], const Pre& pre, const pg8::Unit& u, int wr, int wc, int fr, int fq) const {
        const int row0 = u.pm * 256 + wr * 64 + fr, col0 = u.pn * 256 + wc * 32 + 8 * fq;
#pragma unroll
        for (int ai = 0; ai < 2; ++ai)
#pragma unroll
            for (int m = 0; m < 4; ++m) {
                const int r = row0 + ai * 128 + m * 16;
                const float rs = __builtin_amdgcn_rsqf((float)pre.v[ai * 4 + m] * (1.0f / (1024.0f * 1024.0f)) + 1e-6f);
#pragma unroll
                for (int bj = 0; bj < 2; ++bj) {
                    const f32x4 v0 = acc[ai][bj][m][0] * rs, v1 = acc[ai][bj][m][1] * rs;
                    u32x4 w; w.x = cvt_pk_bf16(v0[0], v0[1]); w.y = cvt_pk_bf16(v0[2], v0[3]); w.z = cvt_pk_bf16(v1[0], v1[1]); w.w = cvt_pk_bf16(v1[2], v1[3]);
                    *(u32x4*)(O + (size_t)r * ldc + col0 + bj * 128) = w;
                }
            }
    }
};
template <bool FINAL> struct EpiResid {
    static constexpr bool PERM = true;
    const _Float16* xin; _Float16* xout; float* outf; bf16_t* xb; unsigned* rowss_next; float scale; LAS unsigned char* lds;
    struct Pre { };
    static constexpr bool LDS_PRE = false;
    __device__ __forceinline__ void prefetch_lds(LAS unsigned char*, const pg8::Unit&, int, int) const {}
    __device__ __forceinline__ void fetch_pre(Pre&, const LAS unsigned char*, int, int) const {}
    __device__ __forceinline__ void operator()(const f32x4 (&acc)[2][2][4][2], const Pre&, const pg8::Unit& u, int wr, int wc, int fr, int fq) const {
        const int row0 = u.pm * 256 + wr * 64 + fr, col0 = u.pn * 256 + wc * 32 + 8 * fq;
        f16x8_t xc[2][4][2];
#pragma unroll
        for (int m = 0; m < 4; ++m) { const _Float16* xp = xin + (size_t)(row0 + m * 16) * DM + col0;
#pragma unroll
            for (int bj = 0; bj < 2; ++bj) xc[0][m][bj] = *(const f16x8_t*)(xp + bj * 128); }
#pragma unroll
        for (int m = 0; m < 2; ++m) { const _Float16* xp = xin + (size_t)(row0 + 128 + m * 16) * DM + col0;
#pragma unroll
            for (int bj = 0; bj < 2; ++bj) xc[1][m][bj] = *(const f16x8_t*)(xp + bj * 128); }
        asm volatile("" ::: "memory");
#pragma unroll
        for (int ai = 0; ai < 2; ++ai)
#pragma unroll
            for (int m = 0; m < 4; ++m) {
                if (ai == 0 && m == 1) {
#pragma unroll
                    for (int m2 = 2; m2 < 4; ++m2) { const _Float16* xp = xin + (size_t)(row0 + 128 + m2 * 16) * DM + col0;
#pragma unroll
                        for (int bj = 0; bj < 2; ++bj) xc[1][m2][bj] = *(const f16x8_t*)(xp + bj * 128); }
                }
                const int r = row0 + ai * 128 + m * 16; const size_t off = (size_t)r * DM + col0; float ss = 0.f;
#pragma unroll
                for (int bj = 0; bj < 2; ++bj) {
                    const f16x8_t xv = xc[ai][m][bj];
                    f32x4 x0, x1;
                    if (STREAM_BF16) { const bf16x8 xb8 = __builtin_bit_cast(bf16x8, xv);
                        x0 = (f32x4){bf2f((unsigned short)xb8[0]), bf2f((unsigned short)xb8[1]), bf2f((unsigned short)xb8[2]), bf2f((unsigned short)xb8[3])}; x1 = (f32x4){bf2f((unsigned short)xb8[4]), bf2f((unsigned short)xb8[5]), bf2f((unsigned short)xb8[6]), bf2f((unsigned short)xb8[7])}; }
                    else { x0 = (f32x4){(float)xv[0], (float)xv[1], (float)xv[2], (float)xv[3]}; x1 = (f32x4){(float)xv[4], (float)xv[5], (float)xv[6], (float)xv[7]}; }
                    const f32x4 o0 = x0 + acc[ai][bj][m][0] * scale, o1 = x1 + acc[ai][bj][m][1] * scale;
                    if (FINAL) { *(f32x4*)(outf + off + bj * 128) = o0; *(f32x4*)(outf + off + bj * 128 + 4) = o1; }
                    else {
                        if (STREAM_BF16) { u32x4 w; w.x = cvt_pk_bf16(o0[0], o0[1]); w.y = cvt_pk_bf16(o0[2], o0[3]); w.z = cvt_pk_bf16(o1[0], o1[1]); w.w = cvt_pk_bf16(o1[2], o1[3]); *(u32x4*)(xout + off + bj * 128) = w; }
                        else {
                        const f16x4_t h0 = __builtin_convertvector(o0, f16x4_t), h1 = __builtin_convertvector(o1, f16x4_t);
                        const f16x8_t hv = {h0[0], h0[1], h0[2], h0[3], h1[0], h1[1], h1[2], h1[3]};
                        *(f16x8_t*)(xout + off + bj * 128) = hv; }
                        ss += (o0[0] * o0[0] + o0[1] * o0[1]) + (o0[2] * o0[2] + o0[3] * o0[3]) + (o1[0] * o1[0] + o1[1] * o1[1]) + (o1[2] * o1[2] + o1[3] * o1[3]);
                    }
                }
                if (!FINAL) { ss += __shfl_xor(ss, 16); ss += __shfl_xor(ss, 32);
                    if (fq == 0) ((LAS float*)(lds + 131072))[((wr * 4 + wc) * 8 + ai * 4 + m) * 16 + fr] = ss; }
            }
        if (!FINAL) {
            asm volatile("s_waitcnt lgkmcnt(0)" ::: "memory"); __builtin_amdgcn_s_barrier(); asm volatile("" ::: "memory");
            if (wc == 0) {
                const int lane = fq * 16 + fr;
#pragma unroll
                for (int hh = 0; hh < 2; ++hh) {
                    const int idx = hh * 64 + lane, g = idx >> 4, f = idx & 15;
                    float t = 0.f;
#pragma unroll
                    for (int w4 = 0; w4 < 4; ++w4) t += ((const LAS float*)(lds + 131072))[((wr * 4 + w4) * 8 + g) * 16 + f];
                    atomicAdd(rowss_next + u.pm * 256 + (g >> 2) * 128 + wr * 64 + (g & 3) * 16 + f, (unsigned)(t * 1024.0f + 0.5f));
                }
            }
        }
    }
};

__device__ __forceinline__ void get_job(const Params& P, int id, const float*& src, bf16_t*& dst, const float*& gain, int& K, int& N, int& mode) {
    unsigned char* ws = P.ws; gain = nullptr; mode = 0;
    if (id < 16) { const int which = id >> 3, ls = id & 7, l = ls >> 1, s = ls & 1;
        src = (which ? P.wu : P.wg) + (size_t)ls * DM * DFF; dst = (bf16_t*)(ws + WS_WGU) + (size_t)ls * 2 * DFF * DM; gain = P.ng + (l * 3 + (s ? 2 : 0)) * DM; K = DM; N = DFF; mode = 1 + which; }
    else if (id < 24) { const int ls = id - 16; src = P.wd + (size_t)ls * DFF * DM; dst = (bf16_t*)(ws + WS_WDN) + (size_t)ls * DFF * DM; K = DFF; N = DM; }
    else if (id < 26) { const int j = id - 24; src = P.abin + (size_t)j * DM * AB_IN; dst = (bf16_t*)(ws + WS_WABIN) + (size_t)j * DM * AB_IN; gain = P.ng + ((2 * j) * 3 + 1) * DM; K = DM; N = AB_IN; }
    else if (id < 28) { const int j = id - 26; src = P.about + (size_t)j * DM * DM; dst = (bf16_t*)(ws + WS_WABOUT) + (size_t)j * DM * DM; K = DM; N = DM; }
    else if (id < 30) { const int j = id - 28; src = P.cin + (size_t)j * DM * HG_IN; dst = (bf16_t*)(ws + WS_WCIN) + (size_t)j * DM * HG_IN; gain = P.ng + ((2 * j + 1) * 3 + 1) * DM; K = DM; N = HG_IN; }
    else if (id < 32) { const int j = id - 30; src = P.cout + (size_t)j * DM * DM; dst = (bf16_t*)(ws + WS_WCOUT) + (size_t)j * DM * DM; K = DM; N = DM; }
    else { const int j = id - 32; src = P.poolw + (size_t)j * 128 * 128; dst = (bf16_t*)(ws + WS_POOLW) + (size_t)j * 128 * 128; K = 128; N = 128; }
}

__device__ void phase0(LAS unsigned char* lds, const Params& P) {
    int tid_ = threadIdx.x; asm volatile("" : "+v"(tid_));
    const int tid = tid_, lane = tid & 63, wave = tid >> 6, G = gridDim.x, bid = blockIdx.x;
    LAS float* tile = (LAS float*)lds;
    for (int id = 0; id < 40; ++id) {
        const float* src; bf16_t* dst; const float* gain; int K, N, mode;
        get_job(P, id, src, dst, gain, K, N, mode);
        const int ntn = N >> 6, ntiles = (K >> 6) * ntn;
        for (int t = bid; t < ntiles; t += G) {
            const int k0 = (t / ntn) << 6, n0 = (t % ntn) << 6;
#pragma unroll
            for (int p = 0; p < 2; ++p) { const int idx = p * 512 + tid, kk = idx >> 4, n4 = (idx & 15) * 4;
                f32x4 v = *(const f32x4*)(src + (size_t)(k0 + kk) * N + n0 + n4); if (gain) v *= gain[k0 + kk];
                tile[kk * 65 + n4] = v[0]; tile[kk * 65 + n4 + 1] = v[1]; tile[kk * 65 + n4 + 2] = v[2]; tile[kk * 65 + n4 + 3] = v[3]; }
            __syncthreads();
#pragma unroll
            for (int p = 0; p < 4; ++p) { const int idx = p * 512 + tid, nn = idx >> 5, kk = (idx & 31) * 2, n = n0 + nn;
                const int drow = mode == 0 ? n : ((n >> 7) * 256 + (n & 127) + (mode == 2 ? 128 : 0));
                const float w0 = tile[kk * 65 + nn], w1 = tile[(kk + 1) * 65 + nn];
                const unsigned wb = cvt_pk_bf16(w0, w1);
                *(unsigned*)(dst + (size_t)drow * K + k0 + kk) = (gain && !STREAM_BF16) ? cvt_pk_f16(__uint_as_float(wb << 16), __uint_as_float(wb & 0xffff0000u)) : wb; }
            __syncthreads();
        }
    }
    bf16_t* xb = (bf16_t*)(P.ws + WS_XB); unsigned* rowss = (unsigned*)(P.ws + WS_ROWSS);
    for (int row0 = (bid * 8 + wave) * 2; row0 < MTOK; row0 += G * 16) {
        f32x4 v[2][4];
#pragma unroll
        for (int rr = 0; rr < 2; ++rr)
#pragma unroll
            for (int i = 0; i < 4; ++i) v[rr][i] = ((const f32x4*)(P.x + (size_t)(row0 + rr) * DM))[lane + 64 * i];
#pragma unroll
        for (int rr = 0; rr < 2; ++rr) { float s = 0.f;
#pragma unroll
            for (int i = 0; i < 4; ++i) { const f32x4 t = v[rr][i]; s += (t[0] * t[0] + t[1] * t[1]) + (t[2] * t[2] + t[3] * t[3]);
                if (STREAM_BF16) { u32x2 w; w.x = cvt_pk_bf16(t[0], t[1]); w.y = cvt_pk_bf16(t[2], t[3]); *(u32x2*)((_Float16*)P.out + (size_t)(row0 + rr) * DM + 4 * (lane + 64 * i)) = w; }
                else *(f16x4_t*)((_Float16*)P.out + (size_t)(row0 + rr) * DM + 4 * (lane + 64 * i)) = __builtin_convertvector(t, f16x4_t); }
#pragma unroll
            for (int o = 32; o >= 1; o >>= 1) s += __shfl_xor(s, o);
            if (lane == 0) rowss[row0 + rr] = (unsigned)(s * 1024.0f + 0.5f); }
    }
    const int gtid = bid * 512 + tid, gthr = G * 512;
#pragma unroll 1
    for (int base = 0; base < 11 * MTOK; base += gthr) { const int i = base + gtid; if (i < 11 * MTOK) rowss[MTOK + i] = 0u; }
    f32x2* rope = (f32x2*)(P.ws + WS_ROPE);
#pragma unroll 1
    for (int base = 0; base < SEQ * 32; base += gthr) { const int i = base + gtid; if (i >= SEQ * 32) break;
        const int t = i >> 5, fi = i & 31;
        const float inv = exp2f(-(float)fi * (13.287712379549449f / 32.0f));
        const float ang = (float)P.pos[t] * inv;
        const double rev = (double)ang * 0.15915494309189535; const float fr = (float)(rev - floor(rev));
        rope[i] = (f32x2){__builtin_amdgcn_cosf(fr), __builtin_amdgcn_sinf(fr)};
    }
    float* lb = (float*)(P.ws + WS_LB);
#pragma unroll 1
    for (int base = 0; base < 1024; base += gthr) { const int i = base + gtid; if (i >= 1024) break; const float l0 = P.lbl[i], l1 = P.lbl[1024 + i]; const float mx = fmaxf(l0, l1);
        const float e0 = expf(l0 - mx), e1 = expf(l1 - mx); const float p0 = e0 / (e0 + e1), p1 = e1 / (e0 + e1); lb[i] = p0 - p0; lb[1024 + i] = (p0 + p1) - p0; }
}

constexpr int KS_STRIDE = 72;
constexpr int VT_STRIDE = 264;
constexpr int ATT_KS_OFF = 0, ATT_VT_OFF = 256 * KS_STRIDE * 2;
constexpr int POOL_US_OFF = 0, POOL_DS_OFF = 144 * 128 * 2, POOL_W_OFF = POOL_DS_OFF + 128 * 136 * 2;

__device__ __forceinline__ void rope8r(bf16x8 a, bf16x8 c, float rs, const float* g, const f32x2* ropep, int fi0, bf16x8& r1, bf16x8& r2) {
    float o1[8], o2[8];
#pragma unroll
    for (int e = 0; e < 8; ++e) { const f32x2 cs = ropep[fi0 + e];
        const float y1 = bf2f((unsigned short)a[e]) * rs * g[fi0 + e], y2 = bf2f((unsigned short)c[e]) * rs * g[32 + fi0 + e]; o1[e] = y1 * cs.x - y2 * cs.y; o2[e] = y2 * cs.x + y1 * cs.y; }
    r1 = pack8(o1[0], o1[1], o1[2], o1[3], o1[4], o1[5], o1[6], o1[7]); r2 = pack8(o2[0], o2[1], o2[2], o2[3], o2[4], o2[5], o2[6], o2[7]);
}
__device__ __forceinline__ void rope8(bf16x8 a, bf16x8 c, float rs, const float* g, const f32x2* ropep, int fi0, LAS bf16_t* d1, LAS bf16_t* d2) {
    bf16x8 r1, r2; rope8r(a, c, rs, g, ropep, fi0, r1, r2); *(LAS bf16x8*)d1 = r1; *(LAS bf16x8*)d2 = r2;
}
__device__ void attn_pool_phase(LAS unsigned char* lds, const Params& P, int j, int rev) {
    int tid_ = threadIdx.x; asm volatile("" : "+v"(tid_));
    const int tid = tid_, lane = tid & 63, wave = __builtin_amdgcn_readfirstlane(tid >> 6), li = lane & 15, lh = lane >> 4;
    const bf16_t* proj = (const bf16_t*)(P.ws + WS_ACT);
    bf16_t* cat = (bf16_t*)(P.ws + WS_CAT);
    const f32x2* rope = (const f32x2*)(P.ws + WS_ROPE);
    const float* qg = P.qg + j * 64; const float* kg = P.kg + j * 64;
    LAS bf16_t* Ks = (LAS bf16_t*)(lds + ATT_KS_OFF); LAS bf16_t* Vt = (LAS bf16_t*)(lds + ATT_VT_OFF);
    for (int item0 = blockIdx.x; item0 < 512; item0 += gridDim.x) {
        const int item = rev ? 511 - item0 : item0;
        const int b = item >> 4, blk = item & 15; const int tok0 = b * SEQ + blk * 128;
        for (int kh = 0; kh < 2; ++kh) {
            __syncthreads();
            {
                const int key = tid >> 1, p = tid & 1; const int tpos = blk * 128 - 128 + key;
                LAS bf16_t* krow = Ks + key * KS_STRIDE;
                if (tpos >= 0) {
                    const bf16_t* kp = proj + (size_t)(b * SEQ + tpos) * AB_IN + 512 + 64 * kh;
                    const bf16x8 a0 = *(const bf16x8*)(kp + 16 * p), a1 = *(const bf16x8*)(kp + 16 * p + 8), c0 = *(const bf16x8*)(kp + 32 + 16 * p), c1 = *(const bf16x8*)(kp + 32 + 16 * p + 8);
                    float ss = 0.f;
#pragma unroll
                    for (int e = 0; e < 8; ++e) { const float u0 = bf2f((unsigned short)a0[e]), u1 = bf2f((unsigned short)a1[e]), u2 = bf2f((unsigned short)c0[e]), u3 = bf2f((unsigned short)c1[e]); ss += (u0 * u0 + u1 * u1) + (u2 * u2 + u3 * u3); }
                    ss += __shfl_xor(ss, 1);
                    const float rs = __builtin_amdgcn_rsqf(ss * (1.0f / 64.0f) + 1e-6f);
                    rope8(a0, c0, rs, kg, rope + tpos * 32, 16 * p, krow + 16 * p, krow + 32 + 16 * p);
                    asm volatile("" ::: "memory");
                    rope8(a1, c1, rs, kg, rope + tpos * 32, 16 * p + 8, krow + 16 * p + 8, krow + 32 + 16 * p + 8);
                    asm volatile("" ::: "memory");
                    const bf16_t* vp = proj + (size_t)(b * SEQ + tpos) * AB_IN + 640 + 64 * kh + 32 * p;
#pragma unroll
                    for (int q4 = 0; q4 < 4; ++q4) { const bf16x8 vv = *(const bf16x8*)(vp + 8 * q4);
#pragma unroll
                        for (int e = 0; e < 8; ++e) Vt[(32 * p + 8 * q4 + e) * VT_STRIDE + key] = (bf16_t)vv[e];
                        if (q4 & 1) asm volatile("" ::: "memory"); }
                } else {
                    const bf16x8 z = {0, 0, 0, 0, 0, 0, 0, 0};
                    *(LAS bf16x8*)(krow + 16 * p) = z; *(LAS bf16x8*)(krow + 16 * p + 8) = z; *(LAS bf16x8*)(krow + 32 + 16 * p) = z; *(LAS bf16x8*)(krow + 32 + 16 * p + 8) = z;
#pragma unroll
                    for (int e = 0; e < 32; ++e) Vt[(32 * p + e) * VT_STRIDE + key] = 0;
                }
            }
            const int hq = wave & 1, hd = 4 * kh + (wave >> 1);
            __syncthreads();
            const float sink2 = P.sinks[j * 8 + hd] * 1.4426950408889634f;
            for (int qs = 0; qs < 2; ++qs) {
            const int q0 = 64 * hq + 32 * qs;
            bf16x8 Qf[2][2];
#pragma unroll
            for (int m = 0; m < 2; ++m) {
                const int ql = q0 + 16 * m + li; const int tpos = blk * 128 + ql;
                const bf16_t* qp = proj + (size_t)(tok0 + ql) * AB_IN + 64 * hd + 8 * lh;
                const bf16x8 a = *(const bf16x8*)qp, c = *(const bf16x8*)(qp + 32);
                float ss = 0.f;
#pragma unroll
                for (int e = 0; e < 8; ++e) { const float u0 = bf2f((unsigned short)a[e]), u1 = bf2f((unsigned short)c[e]); ss += u0 * u0 + u1 * u1; }
                ss += __shfl_xor(ss, 16); ss += __shfl_xor(ss, 32);
                const float rs = __builtin_amdgcn_rsqf(ss * (1.0f / 64.0f) + 1e-6f) * (0.125f * 1.4426950408889634f);
                rope8r(a, c, rs, qg, rope + tpos * 32, 8 * lh, Qf[m][0], Qf[m][1]);
                asm volatile("" ::: "memory");
            }
            float mrow[2], lrow[2];
            f32x4 ot[4][2];
#pragma unroll
            for (int m = 0; m < 2; ++m) { mrow[m] = sink2; lrow[m] = 1.0f;
#pragma unroll
                for (int dm = 0; dm < 4; ++dm) ot[dm][m] = (f32x4){0.f, 0.f, 0.f, 0.f}; }
            for (int kt = hq; kt < hq + 3; ++kt) {
                if (blk == 0 && kt < 2) continue;
                f32x4 st[4][2];
#pragma unroll
                for (int n = 0; n < 4; ++n) {
                    const LAS bf16_t* kr = Ks + (64 * kt + 16 * n + li) * KS_STRIDE + 8 * lh;
                    const bf16x8 k0 = *(const LAS bf16x8*)kr, k1 = *(const LAS bf16x8*)(kr + 32);
#pragma unroll
                    for (int m = 0; m < 2; ++m) { f32x4 a = (f32x4){0.f, 0.f, 0.f, 0.f}; a = MFMA16(k0, Qf[m][0], a); a = MFMA16(k1, Qf[m][1], a); st[n][m] = a; }
                }
#pragma unroll
                for (int m = 0; m < 2; ++m) {
                    const int r = q0 + 16 * m + li;
                    float mx = -INFINITY;
#pragma unroll
                    for (int n = 0; n < 4; ++n)
#pragma unroll
                        for (int e = 0; e < 4; ++e) { const int c = 64 * kt + 16 * n + 4 * lh + e; const bool ok = (c > r) && (c <= r + 128);
                            const float s = ok ? st[n][m][e] : -INFINITY; st[n][m][e] = s; mx = fmaxf(mx, s); }
                    mx = fmaxf(mx, __shfl_xor(mx, 16)); mx = fmaxf(mx, __shfl_xor(mx, 32));
                    const float mn = fmaxf(mrow[m], mx); const float alpha = __builtin_amdgcn_exp2f(mrow[m] - mn); mrow[m] = mn;
                    float ls = 0.f;
#pragma unroll
                    for (int n = 0; n < 4; ++n)
#pragma unroll
                        for (int e = 0; e < 4; ++e) { const float pv = __builtin_amdgcn_exp2f(st[n][m][e] - mn); st[n][m][e] = pv; ls += pv; }
                    ls += __shfl_xor(ls, 16); ls += __shfl_xor(ls, 32);
                    lrow[m] = lrow[m] * alpha + ls;
#pragma unroll
                    for (int dm = 0; dm < 4; ++dm) ot[dm][m] *= alpha;
                }
#pragma unroll
                for (int ks = 0; ks < 2; ++ks) {
                    bf16x8 Pf[2];
#pragma unroll
                    for (int m = 0; m < 2; ++m) Pf[m] = pack8(st[2 * ks][m][0], st[2 * ks][m][1], st[2 * ks][m][2], st[2 * ks][m][3], st[2 * ks + 1][m][0], st[2 * ks + 1][m][1], st[2 * ks + 1][m][2], st[2 * ks + 1][m][3]);
#pragma unroll
                    for (int dm = 0; dm < 4; ++dm) {
                        const LAS bf16_t* vr = Vt + (16 * dm + li) * VT_STRIDE + 64 * kt + 32 * ks + 4 * lh;
                        const bf16x4 v0 = *(const LAS bf16x4*)vr, v1 = *(const LAS bf16x4*)(vr + 16);
                        const bf16x8 Vf = {v0[0], v0[1], v0[2], v0[3], v1[0], v1[1], v1[2], v1[3]};
#pragma unroll
                        for (int m = 0; m < 2; ++m) ot[dm][m] = MFMA16(Vf, Pf[m], ot[dm][m]);
                    }
                }
            }
#pragma unroll
            for (int m = 0; m < 2; ++m) {
                const float inv = 1.0f / lrow[m]; const int ql = q0 + 16 * m + li;
                bf16_t* op = cat + (size_t)(tok0 + ql) * DM + 64 * hd + 4 * lh;
#pragma unroll
                for (int dm = 0; dm < 4; ++dm) { const f32x4 o = ot[dm][m] * inv; u32x2 w; w.x = cvt_pk_bf16(o[0], o[1]); w.y = cvt_pk_bf16(o[2], o[3]); *(u32x2*)(op + 16 * dm) = w; }
            }
            }
        }
        LAS bf16_t* Us = (LAS bf16_t*)(lds + POOL_US_OFF); LAS bf16_t* Ds = (LAS bf16_t*)(lds + POOL_DS_OFF); LAS bf16_t* Wp = (LAS bf16_t*)(lds + POOL_W_OFF);
        for (int g = 0; g < 4; ++g) {
            const int w = 2 << g;
            __syncthreads();
            for (int ch = tid; ch < 144 * 16; ch += 512) { const int rr = ch >> 4, c8 = (ch & 15) * 8; const int ts = blk * 128 - 16 + rr;
                bf16x8 v = {0, 0, 0, 0, 0, 0, 0, 0};
                if (ts >= 0) v = *(const bf16x8*)(proj + (size_t)(b * SEQ + ts) * AB_IN + 768 + 128 * g + c8);
                *(LAS bf16x8*)(Us + rr * 128 + c8) = v; }
            { const bf16_t* wsrc = (const bf16_t*)(P.ws + WS_POOLW) + (size_t)(j * 4 + g) * 128 * 128;
              for (int ch = tid; ch < 128 * 16; ch += 512) { const int n = ch >> 4, c8 = (ch & 15) * 8; *(LAS bf16x8*)(Wp + n * 136 + c8) = *(const bf16x8*)(wsrc + n * 128 + c8); } }
            __syncthreads();
            { const int c = tid & 127, tq = tid >> 7; const int t0 = tq * 32;
              float s = 0.f;
              for (int jj = 0; jj < w; ++jj) s += bf2f(Us[(16 + t0 - jj) * 128 + c]);
              for (int t = t0; t < t0 + 32; ++t) {
                  const float ut = bf2f(Us[(16 + t) * 128 + c]);
                  const int cnt = min(blk * 128 + t + 1, w);
                  Ds[t * 136 + c] = f2bf(s / (float)cnt - ut);
                  if (t + 1 < t0 + 32) s += bf2f(Us[(16 + t + 1) * 128 + c]) - bf2f(Us[(16 + t + 1 - w) * 128 + c]);
              } }
            __syncthreads();
            {
                f32x4 pa[8];
#pragma unroll
                for (int nf = 0; nf < 8; ++nf) pa[nf] = (f32x4){0.f, 0.f, 0.f, 0.f};
#pragma unroll
                for (int ks = 0; ks < 4; ++ks) {
                    const bf16x8 df = *(const LAS bf16x8*)(Ds + (16 * wave + li) * 136 + 32 * ks + 8 * lh);
#pragma unroll
                    for (int nf = 0; nf < 8; ++nf) { const bf16x8 wf = *(const LAS bf16x8*)(Wp + (16 * nf + li) * 136 + 32 * ks + 8 * lh); pa[nf] = MFMA16(wf, df, pa[nf]); }
                }
                const float* psc = P.pools + j * 512 + 128 * g;
                bf16_t* op = cat + (size_t)(tok0 + 16 * wave + li) * DM + 512 + 128 * g + 4 * lh;
#pragma unroll
                for (int nf = 0; nf < 8; ++nf) { const f32x4 sc = *(const f32x4*)(psc + 16 * nf + 4 * lh); const f32x4 o = pa[nf] * sc;
                    u32x2 wv; wv.x = cvt_pk_bf16(o[0], o[1]); wv.y = cvt_pk_bf16(o[2], o[3]); *(u32x2*)(op + 16 * nf) = wv; }
            }
        }
    }
    __syncthreads();
}

constexpr int HG_A1 = 0, HG_AP = 8704, HG_BP = 17408, HG_KDT = 26112, HG_VT = 36352, HG_ST = 46592, HG_SC = 81408, HG_TOT = 83968, HG_RED = 86016;

#define HG_BAR() do { asm volatile("s_waitcnt lgkmcnt(0)" ::: "memory"); __builtin_amdgcn_s_barrier(); asm volatile("" ::: "memory"); } while (0)
__device__ void hgrn_phase(LAS unsigned char* lds, const Params& P, int j, int rev) {
    int tid_ = threadIdx.x; asm volatile("" : "+v"(tid_));
    const int tid = tid_, lane = tid & 63, wave = __builtin_amdgcn_readfirstlane(tid >> 6), li = lane & 15, lh = lane >> 4;
    const bf16_t* proj = (const bf16_t*)(P.ws + WS_ACT);
    bf16_t* cat = (bf16_t*)(P.ws + WS_CAT);
    LAS bf16_t* A1s = (LAS bf16_t*)(lds + HG_A1); LAS bf16_t* Aps = (LAS bf16_t*)(lds + HG_AP); LAS bf16_t* Bps = (LAS bf16_t*)(lds + HG_BP);
    LAS bf16_t* KdT = (LAS bf16_t*)(lds + HG_KDT); LAS bf16_t* VT = (LAS bf16_t*)(lds + HG_VT); LAS bf16_t* St = (LAS bf16_t*)(lds + HG_ST);
    LAS bf16_t* Sc = (LAS bf16_t*)(lds + HG_SC); LAS float* tot = (LAS float*)(lds + HG_TOT); LAS float* red = (LAS float*)(lds + HG_RED);
    const int kc = tid & 127, tg = tid >> 7;
    for (int item0 = blockIdx.x; item0 < 256; item0 += gridDim.x) {
        const int item = rev ? 255 - item0 : item0;
        const int b = item >> 3, h = item & 7;
        const float lb = ((const float*)(P.ws + WS_LB))[j * 1024 + h * 128 + kc];
        f32x4 og4 = *(const f32x4*)(P.cog + j * 128 + 16 * wave + 4 * lh);
        __syncthreads();
        for (int i = tid; i < 128 * 136 / 2; i += 512) ((LAS unsigned*)St)[i] = 0u;
        f32x4 Sacc[8];
#pragma unroll
        for (int vf = 0; vf < 8; ++vf) Sacc[vf] = (f32x4){0.f, 0.f, 0.f, 0.f};
        unsigned short rq[8], rf[8], ri[8];
        { const bf16_t* p0 = proj + (size_t)(b * SEQ + 8 * tg) * HG_IN + h * 128 + kc;
#pragma unroll
          for (int e = 0; e < 8; ++e) { rq[e] = p0[(size_t)e * HG_IN]; rf[e] = p0[(size_t)e * HG_IN + 1024]; ri[e] = p0[(size_t)e * HG_IN + 2048]; } }
        for (int c = 0; c < 64; ++c) {
            const size_t crow = (size_t)(b * SEQ + 32 * c);
            float cs[8], kk[8], qt[8];
            { float run = 0.f;
#pragma unroll
              for (int e = 0; e < 8; ++e) { const float z = bf2f(rf[e]); const float sg = fast_sigmoid(z); const float f = lb + (1.0f - lb) * sg;
                  run += __logf(fmaxf(f, 1e-6f)); cs[e] = run; kk[e] = 1.0f - f; const float qv = bf2f(rq[e]); qt[e] = qv * fast_sigmoid(qv); }
              tot[tg * 128 + kc] = run; }
            bf16x4 gt[2];
#pragma unroll
            for (int m = 0; m < 2; ++m) gt[m] = *(const bf16x4*)(proj + (crow + 16 * m + li) * HG_IN + 3072 + h * 128 + 16 * wave + 4 * lh);
            HG_BAR();
            { const float t0 = tot[kc], t1 = tot[128 + kc], t2 = tot[256 + kc], t3 = tot[384 + kc];
              const float pre = (tg > 0 ? t0 : 0.f) + (tg > 1 ? t1 : 0.f) + (tg > 2 ? t2 : 0.f);
              const float gm = t0 + t1, gl = gm + t2 + t3;
              float kd[8], vv[8];
#pragma unroll
              for (int e = 0; e < 8; ++e) { const float G = pre + cs[e]; const int t = 8 * tg + e;
                  A1s[t * 136 + kc] = f2bf(qt[e] * fast_exp(G)); Aps[t * 136 + kc] = f2bf(qt[e] * fast_exp(G - gm)); Bps[t * 136 + kc] = f2bf(kk[e] * fast_exp(gm - G));
                  kd[e] = kk[e] * fast_exp(gl - G); vv[e] = bf2f(ri[e]); }
              *(LAS bf16x8*)(KdT + kc * 40 + 8 * tg) = pack8(kd[0], kd[1], kd[2], kd[3], kd[4], kd[5], kd[6], kd[7]);
              *(LAS bf16x8*)(VT + kc * 40 + 8 * tg) = pack8(vv[0], vv[1], vv[2], vv[3], vv[4], vv[5], vv[6], vv[7]); }
            if (c + 1 < 64) { const bf16_t* p0 = proj + (crow + 32 + 8 * tg) * HG_IN + h * 128 + kc;
#pragma unroll
              for (int e = 0; e < 8; ++e) { rq[e] = p0[(size_t)e * HG_IN]; rf[e] = p0[(size_t)e * HG_IN + 1024]; ri[e] = p0[(size_t)e * HG_IN + 2048]; } }
            HG_BAR();
            float dec[4];
#pragma unroll
            for (int e = 0; e < 4; ++e) { const int k = 16 * wave + 4 * lh + e; dec[e] = fast_exp(tot[k] + tot[128 + k] + tot[256 + k] + tot[384 + k]); }
            f32x4 oacc[2] = {(f32x4){0.f, 0.f, 0.f, 0.f}, (f32x4){0.f, 0.f, 0.f, 0.f}};
#pragma unroll
            for (int ks = 0; ks < 4; ++ks) {
                const bf16x8 sf = *(const LAS bf16x8*)(St + (16 * wave + li) * 136 + 32 * ks + 8 * lh);
#pragma unroll
                for (int m = 0; m < 2; ++m) { const bf16x8 af = *(const LAS bf16x8*)(A1s + (16 * m + li) * 136 + 32 * ks + 8 * lh); oacc[m] = MFMA16(sf, af, oacc[m]); }
            }
            if (wave < 3) {
                const int sfr = (wave == 2) ? 1 : 0, tfr = (wave == 0) ? 0 : 1;
                f32x4 sa = (f32x4){0.f, 0.f, 0.f, 0.f};
#pragma unroll
                for (int ks = 0; ks < 4; ++ks) { const bf16x8 bf = *(const LAS bf16x8*)(Bps + (16 * sfr + li) * 136 + 32 * ks + 8 * lh); const bf16x8 af = *(const LAS bf16x8*)(Aps + (16 * tfr + li) * 136 + 32 * ks + 8 * lh); sa = MFMA16(bf, af, sa); }
                const int t = 16 * tfr + li;
                float sv[4];
#pragma unroll
                for (int e = 0; e < 4; ++e) { const int s = 16 * sfr + 4 * lh + e; sv[e] = (s <= t) ? sa[e] : 0.f; }
                u32x2 w; w.x = cvt_pk_bf16(sv[0], sv[1]); w.y = cvt_pk_bf16(sv[2], sv[3]); *(LAS u32x2*)(Sc + t * 40 + 16 * sfr + 4 * lh) = w;
            } else if (wave == 3) { u32x2 w; w.x = 0u; w.y = 0u; *(LAS u32x2*)(Sc + li * 40 + 16 + 4 * lh) = w; }
            HG_BAR();
            { const bf16x8 vf = *(const LAS bf16x8*)(VT + (16 * wave + li) * 40 + 8 * lh);
#pragma unroll
              for (int m = 0; m < 2; ++m) { const bf16x8 sf = *(const LAS bf16x8*)(Sc + (16 * m + li) * 40 + 8 * lh); oacc[m] = MFMA16(vf, sf, oacc[m]); } }
#pragma unroll
            for (int m = 0; m < 2; ++m) { float ss = 0.f;
#pragma unroll
                for (int e = 0; e < 4; ++e) { const float o = oacc[m][e] * fast_sigmoid(bf2f((unsigned short)gt[m][e])); oacc[m][e] = o; ss += o * o; }
                ss += __shfl_xor(ss, 16); ss += __shfl_xor(ss, 32);
                if (lh == 0) red[wave * 32 + 16 * m + li] = ss; }
            HG_BAR();
#pragma unroll
            for (int m = 0; m < 2; ++m) { const int t = 16 * m + li; float ss = 0.f;
#pragma unroll
                for (int w8 = 0; w8 < 8; ++w8) ss += red[w8 * 32 + t];
                const float rs = __builtin_amdgcn_rsqf(ss * (1.0f / 128.0f) + 1e-6f);
                const f32x4 o = oacc[m] * rs * og4; u32x2 w; w.x = cvt_pk_bf16(o[0], o[1]); w.y = cvt_pk_bf16(o[2], o[3]);
                *(u32x2*)(cat + (crow + t) * DM + h * 128 + 16 * wave + 4 * lh) = w; }
            { const bf16x8 kf = *(const LAS bf16x8*)(KdT + (16 * wave + li) * 40 + 8 * lh);
#pragma unroll
              for (int vf = 0; vf < 8; ++vf) { const bf16x8 vfr = *(const LAS bf16x8*)(VT + (16 * vf + li) * 40 + 8 * lh);
                  f32x4 s = Sacc[vf]; s[0] *= dec[0]; s[1] *= dec[1]; s[2] *= dec[2]; s[3] *= dec[3];
                  s = MFMA16(kf, vfr, s); Sacc[vf] = s;
                  u32x2 w; w.x = cvt_pk_bf16(s[0], s[1]); w.y = cvt_pk_bf16(s[2], s[3]); *(LAS u32x2*)(St + (16 * vf + li) * 136 + 16 * wave + 4 * lh) = w; } }
        }
    }
    __syncthreads();
}


__device__ __forceinline__ void grid_barrier(unsigned* bar, unsigned k) {
    asm volatile("s_waitcnt vmcnt(0)" ::: "memory");
    __syncthreads();
    if (threadIdx.x == 0) {
        const unsigned ngrp = 8u, gsz = gridDim.x / ngrp, g = blockIdx.x % ngrp;
        __builtin_amdgcn_fence(__ATOMIC_RELEASE, "agent");
        asm volatile("s_waitcnt vmcnt(0)" ::: "memory");
        const unsigned old = __hip_atomic_fetch_add(bar + 64 * g, 1u, __ATOMIC_RELAXED, __HIP_MEMORY_SCOPE_AGENT);
        if (old + 1u == gsz * k) __hip_atomic_fetch_add(bar + 64 * ngrp, 1u, __ATOMIC_RELAXED, __HIP_MEMORY_SCOPE_AGENT);
        while (__hip_atomic_load(bar + 64 * ngrp, __ATOMIC_RELAXED, __HIP_MEMORY_SCOPE_AGENT) < ngrp * k) __builtin_amdgcn_s_sleep(1);
        __builtin_amdgcn_fence(__ATOMIC_ACQUIRE, "agent");
        asm volatile("s_waitcnt vmcnt(0)" ::: "memory");
    }
    __syncthreads();
}
__global__ void __launch_bounds__(512, 2) mega(Params P) {
    extern __shared__ __attribute__((aligned(16))) unsigned char lds_raw[];
    LAS unsigned char* lds = (LAS unsigned char*)lds_raw;
    cg::grid_group grid = cg::this_grid();
    unsigned char* ws = P.ws;
    bf16_t* xb = (bf16_t*)(ws + WS_XB); bf16_t* act = (bf16_t*)(ws + WS_ACT); bf16_t* cat = (bf16_t*)(ws + WS_CAT); unsigned* rowss = (unsigned*)(ws + WS_ROWSS);
    for (int p = P.lo; p < P.hi; ++p) {
        const bf16_t* xhA = (const bf16_t*)((p > NPHASE_K - 3) ? (ws + WS_ACT + 384 * MiB) : (unsigned char*)P.out);
        if (p > P.lo) { if (P.hi > 1000000) grid.sync(); else grid_barrier((unsigned*)(ws + WS_BAR), (unsigned)(p - P.lo)); }
        if (p == 0) { phase0(lds, P); continue; }
        const int q = p - 1, layer = q / 7, step = q % 7, jj = layer >> 1; const bool even = (layer & 1) == 0;
        pg8::StaticOrder S;
        if (step == 0 || step == 5) {
            const int s = step == 0 ? 0 : 1;
            pg8::Gemm g{xhA, (const bf16_t*)(ws + WS_WGU) + (size_t)(layer * 2 + s) * 2 * DFF * DM, MTOK, 2 * DFF, DM}; S.init(MTOK, 2 * DFF, gridDim.x, blockIdx.x, p & 1);
            EpiSwiglu E{act, rowss + (size_t)(layer * 3 + (s ? 2 : 0)) * MTOK};
            pg8::gemm_phase<EpiSwiglu, !STREAM_BF16>(lds, g, S, E);
        } else if (step == 2) {
            const int N = even ? AB_IN : HG_IN;
            const bf16_t* W = even ? (const bf16_t*)(ws + WS_WABIN) + (size_t)jj * DM * AB_IN : (const bf16_t*)(ws + WS_WCIN) + (size_t)jj * DM * HG_IN;
            pg8::Gemm g{xhA, W, MTOK, N, DM}; S.init(MTOK, N, gridDim.x, blockIdx.x, p & 1);
            EpiProj E{act, N, rowss + (size_t)(layer * 3 + 1) * MTOK};
            pg8::gemm_phase<EpiProj, !STREAM_BF16>(lds, g, S, E);
        } else if (step == 3) {
            for (int rep = 0; rep < REP_MIX; ++rep) { if (even) attn_pool_phase(lds, P, jj, p & 1); else hgrn_phase(lds, P, jj, p & 1); }
        } else {
            const bf16_t* A; const bf16_t* W; int K; float scale; int nid;
            if (step == 4) { A = cat; W = even ? (const bf16_t*)(ws + WS_WABOUT) + (size_t)jj * DM * DM : (const bf16_t*)(ws + WS_WCOUT) + (size_t)jj * DM * DM; K = DM; scale = 1.0f; nid = layer * 3 + 2; }
            else { const int s = step == 1 ? 0 : 1; A = act; W = (const bf16_t*)(ws + WS_WDN) + (size_t)(layer * 2 + s) * DFF * DM; K = DFF; scale = 0.5f; nid = s ? (layer + 1) * 3 : layer * 3 + 1; }
            pg8::Gemm g{A, W, MTOK, DM, K}; S.init(MTOK, DM, gridDim.x, blockIdx.x, p & 1);
            _Float16* xh_main = (_Float16*)P.out; _Float16* xh_alt = (_Float16*)(ws + WS_ACT + 384 * MiB);
            if (p == NPHASE_K - 1) { EpiResid<true> E{xh_alt, nullptr, P.out, nullptr, nullptr, scale, lds}; pg8::gemm_phase<EpiResid<true>>(lds, g, S, E); }
            else { EpiResid<false> E{xh_main, (p == NPHASE_K - 3) ? xh_alt : xh_main, nullptr, xb, rowss + (size_t)nid * MTOK, scale, lds}; pg8::gemm_phase<EpiResid<false>>(lds, g, S, E); }
        }
    }
}

constexpr int NPHASE = 29;
#ifndef NRUN
#define NRUN 29
#endif

extern "C" void kernel_launch(void* const* d_in, const int* in_sizes, int n_in, void* d_out, int out_size, void* d_ws, size_t ws_size, hipStream_t stream) {
    static int grid = 0;
    if (grid == 0) {
        if (n_in != 17 || out_size != MTOK * DM || ws_size < WS_END) { fprintf(stderr, "kernel_launch: unexpected shapes (n_in %d out %d ws %zu)\n", n_in, out_size, ws_size); grid = -1; return; }
        int dev = 0, cus = 0, per_cu = 0;
        hipGetDevice(&dev); hipDeviceGetAttribute(&cus, hipDeviceAttributeMultiprocessorCount, dev);
        if (hipFuncSetAttribute((const void*)mega, hipFuncAttributeMaxDynamicSharedMemorySize, LDS_BYTES) != hipSuccess) { fprintf(stderr, "kernel_launch: hipFuncSetAttribute failed\n"); grid = -1; return; }
        if (hipOccupancyMaxActiveBlocksPerMultiprocessor(&per_cu, (const void*)mega, 512, LDS_BYTES) != hipSuccess || per_cu < 1) { fprintf(stderr, "kernel_launch: occupancy query says %d\n", per_cu); per_cu = 1; }
        (void)hipGetLastError();
        grid = cus;
    }
    if (grid < 0) return;
    Params p{};
    p.x = (const float*)d_in[0]; p.pos = (const int*)d_in[1]; p.ng = (const float*)d_in[2]; p.wg = (const float*)d_in[3]; p.wu = (const float*)d_in[4]; p.wd = (const float*)d_in[5];
    p.abin = (const float*)d_in[6]; p.about = (const float*)d_in[7]; p.qg = (const float*)d_in[8]; p.kg = (const float*)d_in[9]; p.sinks = (const float*)d_in[10];
    p.poolw = (const float*)d_in[11]; p.pools = (const float*)d_in[12]; p.cin = (const float*)d_in[13]; p.cout = (const float*)d_in[14]; p.cog = (const float*)d_in[15]; p.lbl = (const float*)d_in[16];
    p.out = (float*)d_out; p.ws = (unsigned char*)d_ws;
#if ONE_LAUNCH
    p.lo = 0; p.hi = NPHASE;
    (void)hipMemsetAsync((unsigned char*)d_ws + WS_BAR, 0, 9 * 256, stream);
    void* args[] = {&p};
    hipError_t e = hipLaunchCooperativeKernel((const void*)mega, dim3(grid), dim3(512), args, LDS_BYTES, stream);
    if (e != hipSuccess) fprintf(stderr, "cooperative launch failed: %s (grid %d)\n", hipGetErrorString(e), grid);
#else
    for (int ph = 0; ph < NRUN; ++ph) { p.lo = ph; p.hi = ph + 1; hipLaunchKernelGGL(mega, dim3(grid), dim3(512), LDS_BYTES, stream, p); }
#endif
}
```

```cpp
#include <hip/hip_runtime.h>
#include <hip/hip_cooperative_groups.h>
#include <cstdio>
namespace cg = cooperative_groups;

#ifndef REP_MIX
#define REP_MIX 1
#endif
#ifndef STREAM_BF16
#define STREAM_BF16 1
#endif
#ifndef ONE_LAUNCH
#define ONE_LAUNCH 1
#endif

#define LAS __attribute__((address_space(3)))
typedef unsigned short bf16_t;
typedef short bf16x8 __attribute__((ext_vector_type(8)));
typedef short bf16x4 __attribute__((ext_vector_type(4)));
typedef float f32x4 __attribute__((ext_vector_type(4)));
typedef float f32x2 __attribute__((ext_vector_type(2)));
typedef unsigned u32x4 __attribute__((ext_vector_type(4)));
typedef unsigned u32x2 __attribute__((ext_vector_type(2)));
typedef _Float16 f16x2_t __attribute__((ext_vector_type(2)));
typedef _Float16 f16x4_t __attribute__((ext_vector_type(4)));
typedef _Float16 f16x8_t __attribute__((ext_vector_type(8)));

constexpr int MTOK = 65536, DM = 1024, DFF = 2816, SEQ = 2048, NB = 32;
constexpr int AB_IN = 1280, HG_IN = 4096;
constexpr int LDS_BYTES = 131072 + 4096 + 2048;

constexpr size_t MiB = 1024ull * 1024ull;
constexpr size_t WS_XB = 0;
constexpr size_t WS_ACT = 128 * MiB;
constexpr size_t WS_CAT = 640 * MiB;
constexpr size_t WS_WGU = 768 * MiB;
constexpr size_t WS_WDN = 856 * MiB;
constexpr size_t WS_WABIN = 900 * MiB;
constexpr size_t WS_WABOUT = 905 * MiB;
constexpr size_t WS_WCIN = 909 * MiB;
constexpr size_t WS_WCOUT = 925 * MiB;
constexpr size_t WS_POOLW = 929 * MiB;
constexpr size_t WS_ROWSS = 930 * MiB;
constexpr size_t WS_ROPE = 938 * MiB;
constexpr size_t WS_LB = 939 * MiB;
constexpr size_t WS_BAR = 940 * MiB;
constexpr size_t WS_END = 941 * MiB;

constexpr int NPHASE_K = 29;
struct Params {
    const float* x; const int* pos; const float* ng; const float* wg; const float* wu; const float* wd;
    const float* abin; const float* about; const float* qg; const float* kg; const float* sinks; const float* poolw; const float* pools;
    const float* cin; const float* cout; const float* cog; const float* lbl;
    float* out; unsigned char* ws; int lo, hi;
};

__device__ __forceinline__ float bf2f(unsigned short b) { return __uint_as_float(((unsigned)b) << 16); }
typedef __bf16 bf16x2_t __attribute__((ext_vector_type(2)));
__device__ __forceinline__ unsigned cvt_pk_bf16(float lo, float hi) { f32x2 v = {lo, hi}; bf16x2_t r = __builtin_convertvector(v, bf16x2_t); return __builtin_bit_cast(unsigned, r); }
__device__ __forceinline__ unsigned cvt_pk_f16(float lo, float hi) { f32x2 v = {lo, hi}; f16x2_t r = __builtin_convertvector(v, f16x2_t); return __builtin_bit_cast(unsigned, r); }
__device__ __forceinline__ bf16_t f2bf(float f) { return (bf16_t)(cvt_pk_bf16(f, 0.f) & 0xffffu); }
__device__ __forceinline__ bf16x8 pack8(float a0, float a1, float a2, float a3, float a4, float a5, float a6, float a7) {
    u32x4 w; w.x = cvt_pk_bf16(a0, a1); w.y = cvt_pk_bf16(a2, a3); w.z = cvt_pk_bf16(a4, a5); w.w = cvt_pk_bf16(a6, a7); return __builtin_bit_cast(bf16x8, w); }
__device__ __forceinline__ float fast_exp(float x) { return __builtin_amdgcn_exp2f(x * 1.4426950408889634f); }
__device__ __forceinline__ float fast_sigmoid(float x) { return __builtin_amdgcn_rcpf(1.0f + fast_exp(-x)); }
__device__ __forceinline__ __amdgpu_buffer_rsrc_t wt_rsrc(void* base) { return __builtin_amdgcn_make_buffer_rsrc(base, 0, 0x7fffffff, 0x00020000); }
__device__ __forceinline__ void wt_store16(u32x4 v, __amdgpu_buffer_rsrc_t r, unsigned byte_off) { __builtin_amdgcn_raw_buffer_store_b128(v, r, (int)byte_off, 0, 16); }
#define MFMA16(a, b, c) __builtin_amdgcn_mfma_f32_16x16x32_bf16((a), (b), (c), 0, 0, 0)

namespace pg8 {
constexpr int BM = 256, BK = 64, HALF = 128, HTB = HALF * BK * 2, STAGE_BYTES = 8 * HTB, NXCD = 8, WGM = 8;
__device__ __forceinline__ int lds_byte(int r, int c) { const int st = (r >> 4) * 2 + (c >> 5), rr = r & 15, cc = c & 31, ob = rr * 64 + cc * 2; return st * 1024 + (ob ^ (((ob >> 9) & 1) << 5)); }
__device__ __forceinline__ void stage_rc(int b, int& R, int& C) { const int st = b / 1024, sb = b % 1024, swz = sb ^ (((sb >> 9) & 1) << 5); R = (st >> 1) * 16 + swz / 64; C = (st & 1) * 32 + (swz % 64) / 2; }
__device__ __forceinline__ int perm32(int rho) { const int n = rho >> 4, i = rho & 15; return 8 * (i >> 2) + 4 * n + (i & 3); }
struct Unit { int pm, pn; };
struct Gemm { const bf16_t* A; const bf16_t* Bt; int M, N, K; };
struct StaticOrder {
    int nM, nN, nwg, G, c, rev;
    __device__ void init(int M, int N, int G_, int c_, int rev_ = 0) { nM = M / BM; nN = N / BM; nwg = nM * nN; G = G_; c = c_; rev = rev_; }
    __device__ bool next(int i, Unit& u) const {
        long L = (long)i * G + c; if (L >= nwg) return false;
        if (rev) L = nwg - 1 - L;
        int wgid = (int)L; { const int q = nwg / NXCD, r = nwg % NXCD, xcd = wgid % NXCD, off = wgid / NXCD; wgid = (xcd < r ? xcd * (q + 1) : r * (q + 1) + (xcd - r) * q) + off; }
        const int nig = WGM * nN, gid = wgid / nig, fm = gid * WGM, gsz = (nM - fm) < WGM ? (nM - fm) : WGM;
        u.pm = fm + ((wgid % nig) % gsz); u.pn = (wgid % nig) / gsz; return true;
    }
};

template <class Epi, bool F16 = false>
__device__ __forceinline__ void gemm_phase(LAS unsigned char* lds, const Gemm g, const StaticOrder& S, const Epi& E) {
    int tid_ = threadIdx.x; asm volatile("" : "+v"(tid_));
    const int tid = tid_, wid = __builtin_amdgcn_readfirstlane(tid >> 6), lane = tid & 63, wr = wid >> 2, wc = wid & 3, fr = lane & 15, fq = lane >> 4;
    const int K = g.K, nt = K / BK;
    unsigned voffA[2], voffB[2];
#pragma unroll
    for (int i = 0; i < 2; ++i) { int R, C; stage_rc(tid * 16 + i * 8192, R, C); const int Rb = Epi::PERM ? ((R & ~31) + perm32(R & 31)) : R;
        voffA[i] = (unsigned)(R * K + C) * 2u; voffB[i] = (unsigned)(Rb * K + C) * 2u; }
    const long kstep = (long)(BK * 2);
    const size_t hstep = (size_t)HALF * K * 2;
    const size_t tstep = 2 * hstep;
    const unsigned ldsw = (unsigned)wid * 1024u;
    const int aoff = lds_byte(wr * 64 + fr, fq * 8), boff = lds_byte(wc * 32 + fr, fq * 8);
#define PG8_SA(b, h) (((b) * 2 + (h)) * HTB)
#define PG8_SB(b, h) ((4 + (b) * 2 + (h)) * HTB)
#define PG8_STAGE(bufoff, gbase, voff) do { _Pragma("unroll") for (int _i = 0; _i < 2; ++_i) \
        __builtin_amdgcn_global_load_lds((const unsigned*)((const char*)(gbase) + (voff)[_i]), (LAS unsigned*)(lds + (bufoff) + ldsw + _i * 8192), 16, 0, 0); } while (0)
#define PG8_LDA(dst, b, h) do { _Pragma("unroll") for (int m = 0; m < 4; ++m) _Pragma("unroll") for (int k = 0; k < 2; ++k) dst[m][k] = *(const LAS bf16x8*)(lds + PG8_SA(b, h) + aoff + m * 2048 + k * 1024); } while (0)
#define PG8_LDB(dst, b, h) do { _Pragma("unroll") for (int n = 0; n < 2; ++n) _Pragma("unroll") for (int k = 0; k < 2; ++k) dst[n][k] = *(const LAS bf16x8*)(lds + PG8_SB(b, h) + boff + n * 2048 + k * 1024); } while (0)
#define PG8_MMA(ai, bj, At, Bt) do { __builtin_amdgcn_s_setprio(1); _Pragma("unroll") for (int m = 0; m < 4; ++m) _Pragma("unroll") for (int n = 0; n < 2; ++n) _Pragma("unroll") for (int k = 0; k < 2; ++k) \
        acc[ai][bj][m][n] = F16 ? __builtin_amdgcn_mfma_f32_16x16x32_f16(__builtin_bit_cast(f16x8_t, Bt[n][k]), __builtin_bit_cast(f16x8_t, At[m][k]), acc[ai][bj][m][n], 0, 0, 0) \
                                : __builtin_amdgcn_mfma_f32_16x16x32_bf16(Bt[n][k], At[m][k], acc[ai][bj][m][n], 0, 0, 0); __builtin_amdgcn_s_setprio(0); } while (0)
#define PG8_WAIT_V(n) asm volatile("s_waitcnt vmcnt(" #n ")" ::: "memory")
#define PG8_WAIT_L(n) asm volatile("s_waitcnt lgkmcnt(" #n ")" ::: "memory")
#define PG8_BAR __builtin_amdgcn_s_barrier()
#define PG8_SCHED __builtin_amdgcn_sched_barrier(0)
    Unit cur, nxt; int ui = 0;
    if (!S.next(0, cur)) return;
    f32x4 acc[2][2][4][2];
#pragma unroll
    for (int a = 0; a < 2; ++a)
#pragma unroll
        for (int b = 0; b < 2; ++b)
#pragma unroll
            for (int m = 0; m < 4; ++m)
#pragma unroll
                for (int n = 0; n < 2; ++n) acc[a][b][m][n] = (f32x4){0.f, 0.f, 0.f, 0.f};
    bf16x8 At[4][2], B0[2][2], B1[2][2];
    typename Epi::Pre pre; LAS unsigned char* const pretab = lds + 131072 + 4096;
    E.prefetch_lds(pretab, cur, wid, lane);
    const char* cA = (const char*)g.A + (size_t)cur.pm * tstep; const char* cB = (const char*)g.Bt + (size_t)cur.pn * tstep;
    int ck = (int)kstep;
    PG8_STAGE(PG8_SB(0, 0), cB, voffB); PG8_STAGE(PG8_SA(0, 0), cA, voffA); PG8_STAGE(PG8_SB(0, 1), cB + hstep, voffB); PG8_STAGE(PG8_SA(0, 1), cA + hstep, voffA);
    if (wr == 1) PG8_BAR;
    PG8_WAIT_V(4); PG8_BAR;
    PG8_STAGE(PG8_SB(1, 0), cB + kstep, voffB); PG8_STAGE(PG8_SA(1, 0), cA + kstep, voffA); PG8_STAGE(PG8_SB(1, 1), cB + hstep + kstep, voffB);
    PG8_WAIT_V(6); PG8_BAR;
    for (;;) {
        const bool has_next = S.next(ui + 1, nxt);
        const int nk = has_next ? -ck : ck; const int nofs = (has_next && nk < 0) ? (nt - 1) * (int)kstep : 0;
        const char* nA = has_next ? (const char*)g.A + (size_t)nxt.pm * tstep + nofs : cA; const char* nB = has_next ? (const char*)g.Bt + (size_t)nxt.pn * tstep + nofs : cB;
        for (int t = 0; t < nt; t += 2) {
            const bool last = (t == nt - 2);
            const char* a1 = cA + (t + 1) * ck;
            const char* a2 = last ? nA : cA + (t + 2) * ck; const char* b2 = last ? nB : cB + (t + 2) * ck;
            const int k3 = last ? nk : ck; const char* a3 = a2 + k3; const char* b3 = b2 + k3;
            PG8_LDB(B0, 0, 0); PG8_SCHED; PG8_LDA(At, 0, 0); PG8_STAGE(PG8_SA(1, 1), a1 + hstep, voffA);
            PG8_WAIT_L(8); PG8_BAR; PG8_WAIT_L(0); PG8_MMA(0, 0, At, B0); PG8_BAR; PG8_SCHED;
            PG8_LDB(B1, 0, 1); PG8_STAGE(PG8_SB(0, 0), b2, voffB);
            PG8_BAR; PG8_WAIT_L(0); PG8_MMA(0, 1, At, B1); PG8_BAR;
            PG8_LDA(At, 0, 1); PG8_STAGE(PG8_SA(0, 0), a2, voffA);
            PG8_BAR; PG8_WAIT_L(0); PG8_MMA(1, 0, At, B0); PG8_BAR; PG8_SCHED;
            PG8_STAGE(PG8_SB(0, 1), b2 + hstep, voffB);
            PG8_WAIT_V(6); PG8_BAR; PG8_MMA(1, 1, At, B1); PG8_BAR;
            PG8_LDB(B0, 1, 0); PG8_SCHED; PG8_LDA(At, 1, 0); PG8_STAGE(PG8_SA(0, 1), a2 + hstep, voffA);
            PG8_WAIT_L(8); PG8_BAR; PG8_WAIT_L(0); PG8_MMA(0, 0, At, B0); PG8_BAR; PG8_SCHED;
            PG8_LDB(B1, 1, 1); PG8_STAGE(PG8_SB(1, 0), b3, voffB);
            PG8_BAR; PG8_WAIT_L(0); PG8_MMA(0, 1, At, B1); PG8_BAR;
            PG8_LDA(At, 1, 1); PG8_STAGE(PG8_SA(1, 0), a3, voffA);
            PG8_BAR; PG8_WAIT_L(0); PG8_MMA(1, 0, At, B0); PG8_BAR; PG8_SCHED;
            PG8_STAGE(PG8_SB(1, 1), b3 + hstep, voffB);
            PG8_WAIT_V(6); PG8_BAR; PG8_MMA(1, 1, At, B1); PG8_BAR;
        }
        E.fetch_pre(pre, pretab + (ui & 1) * 1024, wr, fr);
        E(acc, pre, cur, wr, wc, fr, fq);
        if (!has_next) break;
        E.prefetch_lds(pretab + ((ui + 1) & 1) * 1024, nxt, wid, lane);
#pragma unroll
        for (int a = 0; a < 2; ++a)
#pragma unroll
            for (int b = 0; b < 2; ++b)
#pragma unroll
                for (int m = 0; m < 4; ++m)
#pragma unroll
                    for (int n = 0; n < 2; ++n) acc[a][b][m][n] = (f32x4){0.f, 0.f, 0.f, 0.f};
        cur = nxt; cA = nA; cB = nB; ck = nk; ++ui;
    }
    PG8_WAIT_V(0);
    if (wr == 0) PG8_BAR;
    PG8_BAR;
#undef PG8_SA
#undef PG8_SB
#undef PG8_STAGE
#undef PG8_LDA
#undef PG8_LDB
#undef PG8_MMA
#undef PG8_WAIT_V
#undef PG8_WAIT_L
#undef PG8_BAR
#undef PG8_SCHED
}
}

struct EpiSwiglu {
    static constexpr bool PERM = true;
    bf16_t* O; const unsigned* rowss;
    struct Pre { unsigned v[8]; };
    static constexpr bool LDS_PRE = true;
    __device__ __forceinline__ void prefetch_lds(LAS unsigned char* tab, const pg8::Unit& u, int wid, int lane) const {
        if (wid < 4) __builtin_amdgcn_global_load_lds((const unsigned*)(rowss + u.pm * 256 + wid * 64 + lane), (LAS unsigned*)(tab + wid * 256), 4, 0, 0); }
    __device__ __forceinline__ void fetch_pre(Pre& pre, const LAS unsigned char* tab, int wr, int fr) const {
#pragma unroll
        for (int i = 0; i < 8; ++i) pre.v[i] = ((const LAS unsigned*)tab)[(i >> 2) * 128 + wr * 64 + (i & 3) * 16 + fr]; }
    __device__ __forceinline__ void operator()(const f32x4 (&acc)[2][2][4][2], const Pre& pre, const pg8::Unit& u, int wr, int wc, int fr, int fq) const {
        const int row0 = u.pm * 256 + wr * 64 + fr, h0 = u.pn * 128 + wc * 32 + 8 * fq;
        const __amdgpu_buffer_rsrc_t rO = wt_rsrc(O);
#pragma unroll
        for (int ai = 0; ai < 2; ++ai)
#pragma unroll
            for (int m = 0; m < 4; ++m) {
                const int r = row0 + ai * 128 + m * 16;
                const float rs = __builtin_amdgcn_rsqf((float)pre.v[ai * 4 + m] * (1.0f / (1024.0f * 1024.0f)) + 1e-6f);
                float o[8];
#pragma unroll
                for (int n = 0; n < 2; ++n)
#pragma unroll
                    for (int j = 0; j < 4; ++j) { const float gv = acc[ai][0][m][n][j] * rs, uv = acc[ai][1][m][n][j] * rs; o[n * 4 + j] = gv * uv * fast_sigmoid(gv); }
                u32x4 w; w.x = cvt_pk_bf16(o[0], o[1]); w.y = cvt_pk_bf16(o[2], o[3]); w.z = cvt_pk_bf16(o[4], o[5]); w.w = cvt_pk_bf16(o[6], o[7]);
                wt_store16(w, rO, (unsigned)(r * DFF + h0) * 2u);
            }
    }
};
struct EpiProj {
    static constexpr bool PERM = true;
    bf16_t* O; int ldc; const unsigned* rowss;
    struct Pre { unsigned v[8]; };
    static constexpr bool LDS_PRE = true;
    __device__ __forceinline__ void prefetch_lds(LAS unsigned char* tab, const pg8::Unit& u, int wid, int lane) const {
        if (wid < 4) __builtin_amdgcn_global_load_lds((const unsigned*)(rowss + u.pm * 256 + wid * 64 + lane), (LAS unsigned*)(tab + wid * 256), 4, 0, 0); }
    __device__ __forceinline__ void fetch_pre(Pre& pre, const LAS unsigned char* tab, int wr, int fr) const {
#pragma unroll
        for (int i = 0; i < 8; ++i) pre.v[i] = ((const LAS unsigned*)tab)[(i >> 2) * 128 + wr * 64 + (i & 3) * 16 + fr]; }
    __device__ __forceinline__ void operator()(const f32x4 (&acc)[2][2][4][2], const Pre& pre, const pg8::Unit& u, int wr, int wc, int fr, int fq) const {
        const int row0 = u.pm * 256 + wr * 64 + fr, col0 = u.pn * 256 + wc * 32 + 8 * fq;
        const __amdgpu_buffer_rsrc_t rO = wt_rsrc(O);
#pragma unroll
        for (int ai = 0; ai < 2; ++ai)
#pragma unroll
            for (int m = 0; m < 4; ++m) {
                const int r = row0 + ai * 128 + m * 16;
                const float rs = __builtin_amdgcn_rsqf((float)pre.v[ai * 4 + m] * (1.0f / (1024.0f * 1024.0f)) + 1e-6f);
#pragma unroll
                for (int bj = 0; bj < 2; ++bj) {
                    const f32x4 v0 = acc[ai][bj][m][0] * rs, v1 = acc[ai][bj][m][1] * rs;
                    u32x4 w; w.x = cvt_pk_bf16(v0[0], v0[1]); w.y = cvt_pk_bf16(v0[2], v0[3]); w.z = cvt_pk_bf16(v1[0], v1[1]); w.w = cvt_pk_bf16(v1[2], v1[3]);
                    wt_store16(w, rO, (unsigned)(r * ldc + col0 + bj * 128) * 2u);
                }
            }
    }
};
template <bool FINAL> struct EpiResid {
    static constexpr bool PERM = true;
    const _Float16* xin; _Float16* xout; float* outf; bf16_t* xb; unsigned* rowss_next; float scale; LAS unsigned char* lds;
    struct Pre { };
    static constexpr bool LDS_PRE = false;
    __device__ __forceinline__ void prefetch_lds(LAS unsigned char*, const pg8::Unit&, int, int) const {}
    __device__ __forceinline__ void fetch_pre(Pre&, const LAS unsigned char*, int, int) const {}
    __device__ __forceinline__ void operator()(const f32x4 (&acc)[2][2][4][2], const Pre&, const pg8::Unit& u, int wr, int wc, int fr, int fq) const {
        const int row0 = u.pm * 256 + wr * 64 + fr, col0 = u.pn * 256 + wc * 32 + 8 * fq;
        f16x8_t xc[2][4][2];
#pragma unroll
        for (int m = 0; m < 4; ++m) { const _Float16* xp = xin + (size_t)(row0 + m * 16) * DM + col0;
#pragma unroll
            for (int bj = 0; bj < 2; ++bj) xc[0][m][bj] = *(const f16x8_t*)(xp + bj * 128); }
#pragma unroll
        for (int m = 0; m < 2; ++m) { const _Float16* xp = xin + (size_t)(row0 + 128 + m * 16) * DM + col0;
#pragma unroll
            for (int bj = 0; bj < 2; ++bj) xc[1][m][bj] = *(const f16x8_t*)(xp + bj * 128); }
        asm volatile("" ::: "memory");
#pragma unroll
        for (int ai = 0; ai < 2; ++ai)
#pragma unroll
            for (int m = 0; m < 4; ++m) {
                if (ai == 0 && m == 1) {
#pragma unroll
                    for (int m2 = 2; m2 < 4; ++m2) { const _Float16* xp = xin + (size_t)(row0 + 128 + m2 * 16) * DM + col0;
#pragma unroll
                        for (int bj = 0; bj < 2; ++bj) xc[1][m2][bj] = *(const f16x8_t*)(xp + bj * 128); }
                }
                const int r = row0 + ai * 128 + m * 16; const size_t off = (size_t)r * DM + col0; float ss = 0.f;
#pragma unroll
                for (int bj = 0; bj < 2; ++bj) {
                    const f16x8_t xv = xc[ai][m][bj];
                    f32x4 x0, x1;
                    if (STREAM_BF16) { const bf16x8 xb8 = __builtin_bit_cast(bf16x8, xv);
                        x0 = (f32x4){bf2f((unsigned short)xb8[0]), bf2f((unsigned short)xb8[1]), bf2f((unsigned short)xb8[2]), bf2f((unsigned short)xb8[3])}; x1 = (f32x4){bf2f((unsigned short)xb8[4]), bf2f((unsigned short)xb8[5]), bf2f((unsigned short)xb8[6]), bf2f((unsigned short)xb8[7])}; }
                    else { x0 = (f32x4){(float)xv[0], (float)xv[1], (float)xv[2], (float)xv[3]}; x1 = (f32x4){(float)xv[4], (float)xv[5], (float)xv[6], (float)xv[7]}; }
                    const f32x4 o0 = x0 + acc[ai][bj][m][0] * scale, o1 = x1 + acc[ai][bj][m][1] * scale;
                    if (FINAL) { *(f32x4*)(outf + off + bj * 128) = o0; *(f32x4*)(outf + off + bj * 128 + 4) = o1; }
                    else {
                        if (STREAM_BF16) { u32x4 w; w.x = cvt_pk_bf16(o0[0], o0[1]); w.y = cvt_pk_bf16(o0[2], o0[3]); w.z = cvt_pk_bf16(o1[0], o1[1]); w.w = cvt_pk_bf16(o1[2], o1[3]); wt_store16(w, wt_rsrc(xout), (unsigned)(off + bj * 128) * 2u); }
                        else {
                        const f16x4_t h0 = __builtin_convertvector(o0, f16x4_t), h1 = __builtin_convertvector(o1, f16x4_t);
                        const f16x8_t hv = {h0[0], h0[1], h0[2], h0[3], h1[0], h1[1], h1[2], h1[3]};
                        *(f16x8_t*)(xout + off + bj * 128) = hv; }
                        ss += (o0[0] * o0[0] + o0[1] * o0[1]) + (o0[2] * o0[2] + o0[3] * o0[3]) + (o1[0] * o1[0] + o1[1] * o1[1]) + (o1[2] * o1[2] + o1[3] * o1[3]);
                    }
                }
                if (!FINAL) { ss += __shfl_xor(ss, 16); ss += __shfl_xor(ss, 32);
                    if (fq == 0) ((LAS float*)(lds + 131072))[((wr * 4 + wc) * 8 + ai * 4 + m) * 16 + fr] = ss; }
            }
        if (!FINAL) {
            asm volatile("s_waitcnt lgkmcnt(0)" ::: "memory"); __builtin_amdgcn_s_barrier(); asm volatile("" ::: "memory");
            if (wc == 0) {
                const int lane = fq * 16 + fr;
#pragma unroll
                for (int hh = 0; hh < 2; ++hh) {
                    const int idx = hh * 64 + lane, g = idx >> 4, f = idx & 15;
                    float t = 0.f;
#pragma unroll
                    for (int w4 = 0; w4 < 4; ++w4) t += ((const LAS float*)(lds + 131072))[((wr * 4 + w4) * 8 + g) * 16 + f];
                    atomicAdd(rowss_next + u.pm * 256 + (g >> 2) * 128 + wr * 64 + (g & 3) * 16 + f, (unsigned)(t * 1024.0f + 0.5f));
                }
            }
        }
    }
};

__device__ __forceinline__ void get_job(const Params& P, int id, const float*& src, bf16_t*& dst, const float*& gain, int& K, int& N, int& mode) {
    unsigned char* ws = P.ws; gain = nullptr; mode = 0;
    if (id < 16) { const int which = id >> 3, ls = id & 7, l = ls >> 1, s = ls & 1;
        src = (which ? P.wu : P.wg) + (size_t)ls * DM * DFF; dst = (bf16_t*)(ws + WS_WGU) + (size_t)ls * 2 * DFF * DM; gain = P.ng + (l * 3 + (s ? 2 : 0)) * DM; K = DM; N = DFF; mode = 1 + which; }
    else if (id < 24) { const int ls = id - 16; src = P.wd + (size_t)ls * DFF * DM; dst = (bf16_t*)(ws + WS_WDN) + (size_t)ls * DFF * DM; K = DFF; N = DM; }
    else if (id < 26) { const int j = id - 24; src = P.abin + (size_t)j * DM * AB_IN; dst = (bf16_t*)(ws + WS_WABIN) + (size_t)j * DM * AB_IN; gain = P.ng + ((2 * j) * 3 + 1) * DM; K = DM; N = AB_IN; }
    else if (id < 28) { const int j = id - 26; src = P.about + (size_t)j * DM * DM; dst = (bf16_t*)(ws + WS_WABOUT) + (size_t)j * DM * DM; K = DM; N = DM; }
    else if (id < 30) { const int j = id - 28; src = P.cin + (size_t)j * DM * HG_IN; dst = (bf16_t*)(ws + WS_WCIN) + (size_t)j * DM * HG_IN; gain = P.ng + ((2 * j + 1) * 3 + 1) * DM; K = DM; N = HG_IN; }
    else if (id < 32) { const int j = id - 30; src = P.cout + (size_t)j * DM * DM; dst = (bf16_t*)(ws + WS_WCOUT) + (size_t)j * DM * DM; K = DM; N = DM; }
    else { const int j = id - 32; src = P.poolw + (size_t)j * 128 * 128; dst = (bf16_t*)(ws + WS_POOLW) + (size_t)j * 128 * 128; K = 128; N = 128; }
}

__device__ void phase0(LAS unsigned char* lds, const Params& P) {
    int tid_ = threadIdx.x; asm volatile("" : "+v"(tid_));
    const int tid = tid_, lane = tid & 63, wave = tid >> 6, G = gridDim.x, bid = blockIdx.x;
    LAS float* tile = (LAS float*)lds;
    for (int id = 0; id < 40; ++id) {
        const float* src; bf16_t* dst; const float* gain; int K, N, mode;
        get_job(P, id, src, dst, gain, K, N, mode);
        const int ntn = N >> 6, ntiles = (K >> 6) * ntn;
        for (int t = bid; t < ntiles; t += G) {
            const int k0 = (t / ntn) << 6, n0 = (t % ntn) << 6;
#pragma unroll
            for (int p = 0; p < 2; ++p) { const int idx = p * 512 + tid, kk = idx >> 4, n4 = (idx & 15) * 4;
                f32x4 v = *(const f32x4*)(src + (size_t)(k0 + kk) * N + n0 + n4); if (gain) v *= gain[k0 + kk];
                tile[kk * 65 + n4] = v[0]; tile[kk * 65 + n4 + 1] = v[1]; tile[kk * 65 + n4 + 2] = v[2]; tile[kk * 65 + n4 + 3] = v[3]; }
            __syncthreads();
#pragma unroll
            for (int p = 0; p < 4; ++p) { const int idx = p * 512 + tid, nn = idx >> 5, kk = (idx & 31) * 2, n = n0 + nn;
                const int drow = mode == 0 ? n : ((n >> 7) * 256 + (n & 127) + (mode == 2 ? 128 : 0));
                const float w0 = tile[kk * 65 + nn], w1 = tile[(kk + 1) * 65 + nn];
                const unsigned wb = cvt_pk_bf16(w0, w1);
                *(unsigned*)(dst + (size_t)drow * K + k0 + kk) = (gain && !STREAM_BF16) ? cvt_pk_f16(__uint_as_float(wb << 16), __uint_as_float(wb & 0xffff0000u)) : wb; }
            __syncthreads();
        }
    }
    bf16_t* xb = (bf16_t*)(P.ws + WS_XB); unsigned* rowss = (unsigned*)(P.ws + WS_ROWSS);
    for (int row0 = (bid * 8 + wave) * 2; row0 < MTOK; row0 += G * 16) {
        f32x4 v[2][4];
#pragma unroll
        for (int rr = 0; rr < 2; ++rr)
#pragma unroll
            for (int i = 0; i < 4; ++i) v[rr][i] = ((const f32x4*)(P.x + (size_t)(row0 + rr) * DM))[lane + 64 * i];
#pragma unroll
        for (int rr = 0; rr < 2; ++rr) { float s = 0.f;
#pragma unroll
            for (int i = 0; i < 4; ++i) { const f32x4 t = v[rr][i]; s += (t[0] * t[0] + t[1] * t[1]) + (t[2] * t[2] + t[3] * t[3]);
                if (STREAM_BF16) { u32x2 w; w.x = cvt_pk_bf16(t[0], t[1]); w.y = cvt_pk_bf16(t[2], t[3]); *(u32x2*)((_Float16*)P.out + (size_t)(row0 + rr) * DM + 4 * (lane + 64 * i)) = w; }
                else *(f16x4_t*)((_Float16*)P.out + (size_t)(row0 + rr) * DM + 4 * (lane + 64 * i)) = __builtin_convertvector(t, f16x4_t); }
#pragma unroll
            for (int o = 32; o >= 1; o >>= 1) s += __shfl_xor(s, o);
            if (lane == 0) rowss[row0 + rr] = (unsigned)(s * 1024.0f + 0.5f); }
    }
    const int gtid = bid * 512 + tid, gthr = G * 512;
#pragma unroll 1
    for (int base = 0; base < 11 * MTOK; base += gthr) { const int i = base + gtid; if (i < 11 * MTOK) rowss[MTOK + i] = 0u; }
    f32x2* rope = (f32x2*)(P.ws + WS_ROPE);
#pragma unroll 1
    for (int base = 0; base < SEQ * 32; base += gthr) { const int i = base + gtid; if (i >= SEQ * 32) break;
        const int t = i >> 5, fi = i & 31;
        const float inv = exp2f(-(float)fi * (13.287712379549449f / 32.0f));
        const float ang = (float)P.pos[t] * inv;
        const double rev = (double)ang * 0.15915494309189535; const float fr = (float)(rev - floor(rev));
        rope[i] = (f32x2){__builtin_amdgcn_cosf(fr), __builtin_amdgcn_sinf(fr)};
    }
    float* lb = (float*)(P.ws + WS_LB);
#pragma unroll 1
    for (int base = 0; base < 1024; base += gthr) { const int i = base + gtid; if (i >= 1024) break; const float l0 = P.lbl[i], l1 = P.lbl[1024 + i]; const float mx = fmaxf(l0, l1);
        const float e0 = expf(l0 - mx), e1 = expf(l1 - mx); const float p0 = e0 / (e0 + e1), p1 = e1 / (e0 + e1); lb[i] = p0 - p0; lb[1024 + i] = (p0 + p1) - p0; }
}

constexpr int KS_STRIDE = 72;
constexpr int VT_STRIDE = 264;
constexpr int ATT_KS_OFF = 0, ATT_VT_OFF = 256 * KS_STRIDE * 2;
constexpr int POOL_US_OFF = 0, POOL_DS_OFF = 144 * 128 * 2, POOL_W_OFF = POOL_DS_OFF + 128 * 136 * 2;

__device__ __forceinline__ void rope8r(bf16x8 a, bf16x8 c, float rs, const float* g, const f32x2* ropep, int fi0, bf16x8& r1, bf16x8& r2) {
    float o1[8], o2[8];
#pragma unroll
    for (int e = 0; e < 8; ++e) { const f32x2 cs = ropep[fi0 + e];
        const float y1 = bf2f((unsigned short)a[e]) * rs * g[fi0 + e], y2 = bf2f((unsigned short)c[e]) * rs * g[32 + fi0 + e]; o1[e] = y1 * cs.x - y2 * cs.y; o2[e] = y2 * cs.x + y1 * cs.y; }
    r1 = pack8(o1[0], o1[1], o1[2], o1[3], o1[4], o1[5], o1[6], o1[7]); r2 = pack8(o2[0], o2[1], o2[2], o2[3], o2[4], o2[5], o2[6], o2[7]);
}
__device__ __forceinline__ void rope8(bf16x8 a, bf16x8 c, float rs, const float* g, const f32x2* ropep, int fi0, LAS bf16_t* d1, LAS bf16_t* d2) {
    bf16x8 r1, r2; rope8r(a, c, rs, g, ropep, fi0, r1, r2); *(LAS bf16x8*)d1 = r1; *(LAS bf16x8*)d2 = r2;
}
__device__ void attn_pool_phase(LAS unsigned char* lds, const Params& P, int j, int rev) {
    int tid_ = threadIdx.x; asm volatile("" : "+v"(tid_));
    const int tid = tid_, lane = tid & 63, wave = __builtin_amdgcn_readfirstlane(tid >> 6), li = lane & 15, lh = lane >> 4;
    const bf16_t* proj = (const bf16_t*)(P.ws + WS_ACT);
    bf16_t* cat = (bf16_t*)(P.ws + WS_CAT);
    const f32x2* rope = (const f32x2*)(P.ws + WS_ROPE);
    const float* qg = P.qg + j * 64; const float* kg = P.kg + j * 64;
    LAS bf16_t* Ks = (LAS bf16_t*)(lds + ATT_KS_OFF); LAS bf16_t* Vt = (LAS bf16_t*)(lds + ATT_VT_OFF);
    for (int item0 = blockIdx.x; item0 < 512; item0 += gridDim.x) {
        const int item = rev ? 511 - item0 : item0;
        const int b = item >> 4, blk = item & 15; const int tok0 = b * SEQ + blk * 128;
        for (int kh = 0; kh < 2; ++kh) {
            __syncthreads();
            {
                const int key = tid >> 1, p = tid & 1; const int tpos = blk * 128 - 128 + key;
                LAS bf16_t* krow = Ks + key * KS_STRIDE;
                if (tpos >= 0) {
                    const bf16_t* kp = proj + (size_t)(b * SEQ + tpos) * AB_IN + 512 + 64 * kh;
                    const bf16x8 a0 = *(const bf16x8*)(kp + 16 * p), a1 = *(const bf16x8*)(kp + 16 * p + 8), c0 = *(const bf16x8*)(kp + 32 + 16 * p), c1 = *(const bf16x8*)(kp + 32 + 16 * p + 8);
                    float ss = 0.f;
#pragma unroll
                    for (int e = 0; e < 8; ++e) { const float u0 = bf2f((unsigned short)a0[e]), u1 = bf2f((unsigned short)a1[e]), u2 = bf2f((unsigned short)c0[e]), u3 = bf2f((unsigned short)c1[e]); ss += (u0 * u0 + u1 * u1) + (u2 * u2 + u3 * u3); }
                    ss += __shfl_xor(ss, 1);
                    const float rs = __builtin_amdgcn_rsqf(ss * (1.0f / 64.0f) + 1e-6f);
                    rope8(a0, c0, rs, kg, rope + tpos * 32, 16 * p, krow + 16 * p, krow + 32 + 16 * p);
                    asm volatile("" ::: "memory");
                    rope8(a1, c1, rs, kg, rope + tpos * 32, 16 * p + 8, krow + 16 * p + 8, krow + 32 + 16 * p + 8);
                    asm volatile("" ::: "memory");
                    const bf16_t* vp = proj + (size_t)(b * SEQ + tpos) * AB_IN + 640 + 64 * kh + 32 * p;
#pragma unroll
                    for (int q4 = 0; q4 < 4; ++q4) { const bf16x8 vv = *(const bf16x8*)(vp + 8 * q4);
#pragma unroll
                        for (int e = 0; e < 8; ++e) Vt[(32 * p + 8 * q4 + e) * VT_STRIDE + key] = (bf16_t)vv[e];
                        if (q4 & 1) asm volatile("" ::: "memory"); }
                } else {
                    const bf16x8 z = {0, 0, 0, 0, 0, 0, 0, 0};
                    *(LAS bf16x8*)(krow + 16 * p) = z; *(LAS bf16x8*)(krow + 16 * p + 8) = z; *(LAS bf16x8*)(krow + 32 + 16 * p) = z; *(LAS bf16x8*)(krow + 32 + 16 * p + 8) = z;
#pragma unroll
                    for (int e = 0; e < 32; ++e) Vt[(32 * p + e) * VT_STRIDE + key] = 0;
                }
            }
            const int hq = wave & 1, hd = 4 * kh + (wave >> 1);
            __syncthreads();
            const float sink2 = P.sinks[j * 8 + hd] * 1.4426950408889634f;
            for (int qs = 0; qs < 2; ++qs) {
            const int q0 = 64 * hq + 32 * qs;
            bf16x8 Qf[2][2];
#pragma unroll
            for (int m = 0; m < 2; ++m) {
                const int ql = q0 + 16 * m + li; const int tpos = blk * 128 + ql;
                const bf16_t* qp = proj + (size_t)(tok0 + ql) * AB_IN + 64 * hd + 8 * lh;
                const bf16x8 a = *(const bf16x8*)qp, c = *(const bf16x8*)(qp + 32);
                float ss = 0.f;
#pragma unroll
                for (int e = 0; e < 8; ++e) { const float u0 = bf2f((unsigned short)a[e]), u1 = bf2f((unsigned short)c[e]); ss += u0 * u0 + u1 * u1; }
                ss += __shfl_xor(ss, 16); ss += __shfl_xor(ss, 32);
                const float rs = __builtin_amdgcn_rsqf(ss * (1.0f / 64.0f) + 1e-6f) * (0.125f * 1.4426950408889634f);
                rope8r(a, c, rs, qg, rope + tpos * 32, 8 * lh, Qf[m][0], Qf[m][1]);
                asm volatile("" ::: "memory");
            }
            float mrow[2], lrow[2];
            f32x4 ot[4][2];
#pragma unroll
            for (int m = 0; m < 2; ++m) { mrow[m] = sink2; lrow[m] = 1.0f;
#pragma unroll
                for (int dm = 0; dm < 4; ++dm) ot[dm][m] = (f32x4){0.f, 0.f, 0.f, 0.f}; }
            for (int kt = hq; kt < hq + 3; ++kt) {
                if (blk == 0 && kt < 2) continue;
                f32x4 st[4][2];
#pragma unroll
                for (int n = 0; n < 4; ++n) {
                    const LAS bf16_t* kr = Ks + (64 * kt + 16 * n + li) * KS_STRIDE + 8 * lh;
                    const bf16x8 k0 = *(const LAS bf16x8*)kr, k1 = *(const LAS bf16x8*)(kr + 32);
#pragma unroll
                    for (int m = 0; m < 2; ++m) { f32x4 a = (f32x4){0.f, 0.f, 0.f, 0.f}; a = MFMA16(k0, Qf[m][0], a); a = MFMA16(k1, Qf[m][1], a); st[n][m] = a; }
                }
#pragma unroll
                for (int m = 0; m < 2; ++m) {
                    const int r = q0 + 16 * m + li;
                    float mx = -INFINITY;
#pragma unroll
                    for (int n = 0; n < 4; ++n)
#pragma unroll
                        for (int e = 0; e < 4; ++e) { const int c = 64 * kt + 16 * n + 4 * lh + e; const bool ok = (c > r) && (c <= r + 128);
                            const float s = ok ? st[n][m][e] : -INFINITY; st[n][m][e] = s; mx = fmaxf(mx, s); }
                    mx = fmaxf(mx, __shfl_xor(mx, 16)); mx = fmaxf(mx, __shfl_xor(mx, 32));
                    const float mn = fmaxf(mrow[m], mx); const float alpha = __builtin_amdgcn_exp2f(mrow[m] - mn); mrow[m] = mn;
                    float ls = 0.f;
#pragma unroll
                    for (int n = 0; n < 4; ++n)
#pragma unroll
                        for (int e = 0; e < 4; ++e) { const float pv = __builtin_amdgcn_exp2f(st[n][m][e] - mn); st[n][m][e] = pv; ls += pv; }
                    ls += __shfl_xor(ls, 16); ls += __shfl_xor(ls, 32);
                    lrow[m] = lrow[m] * alpha + ls;
#pragma unroll
                    for (int dm = 0; dm < 4; ++dm) ot[dm][m] *= alpha;
                }
#pragma unroll
                for (int ks = 0; ks < 2; ++ks) {
                    bf16x8 Pf[2];
#pragma unroll
                    for (int m = 0; m < 2; ++m) Pf[m] = pack8(st[2 * ks][m][0], st[2 * ks][m][1], st[2 * ks][m][2], st[2 * ks][m][3], st[2 * ks + 1][m][0], st[2 * ks + 1][m][1], st[2 * ks + 1][m][2], st[2 * ks + 1][m][3]);
#pragma unroll
                    for (int dm = 0; dm < 4; ++dm) {
                        const LAS bf16_t* vr = Vt + (16 * dm + li) * VT_STRIDE + 64 * kt + 32 * ks + 4 * lh;
                        const bf16x4 v0 = *(const LAS bf16x4*)vr, v1 = *(const LAS bf16x4*)(vr + 16);
                        const bf16x8 Vf = {v0[0], v0[1], v0[2], v0[3], v1[0], v1[1], v1[2], v1[3]};
#pragma unroll
                        for (int m = 0; m < 2; ++m) ot[dm][m] = MFMA16(Vf, Pf[m], ot[dm][m]);
                    }
                }
            }
#pragma unroll
            for (int m = 0; m < 2; ++m) {
                const float inv = 1.0f / lrow[m]; const int ql = q0 + 16 * m + li;
                bf16_t* op = cat + (size_t)(tok0 + ql) * DM + 64 * hd + 4 * lh;
#pragma unroll
                for (int dm = 0; dm < 4; ++dm) { const f32x4 o = ot[dm][m] * inv; u32x2 w; w.x = cvt_pk_bf16(o[0], o[1]); w.y = cvt_pk_bf16(o[2], o[3]); *(u32x2*)(op + 16 * dm) = w; }
            }
            }
        }
        LAS bf16_t* Us = (LAS bf16_t*)(lds + POOL_US_OFF); LAS bf16_t* Ds = (LAS bf16_t*)(lds + POOL_DS_OFF); LAS bf16_t* Wp = (LAS bf16_t*)(lds + POOL_W_OFF);
        for (int g = 0; g < 4; ++g) {
            const int w = 2 << g;
            __syncthreads();
            for (int ch = tid; ch < 144 * 16; ch += 512) { const int rr = ch >> 4, c8 = (ch & 15) * 8; const int ts = blk * 128 - 16 + rr;
                bf16x8 v = {0, 0, 0, 0, 0, 0, 0, 0};
                if (ts >= 0) v = *(const bf16x8*)(proj + (size_t)(b * SEQ + ts) * AB_IN + 768 + 128 * g + c8);
                *(LAS bf16x8*)(Us + rr * 128 + c8) = v; }
            { const bf16_t* wsrc = (const bf16_t*)(P.ws + WS_POOLW) + (size_t)(j * 4 + g) * 128 * 128;
              for (int ch = tid; ch < 128 * 16; ch += 512) { const int n = ch >> 4, c8 = (ch & 15) * 8; *(LAS bf16x8*)(Wp + n * 136 + c8) = *(const bf16x8*)(wsrc + n * 128 + c8); } }
            __syncthreads();
            { const int c = tid & 127, tq = tid >> 7; const int t0 = tq * 32;
              float s = 0.f;
              for (int jj = 0; jj < w; ++jj) s += bf2f(Us[(16 + t0 - jj) * 128 + c]);
              for (int t = t0; t < t0 + 32; ++t) {
                  const float ut = bf2f(Us[(16 + t) * 128 + c]);
                  const int cnt = min(blk * 128 + t + 1, w);
                  Ds[t * 136 + c] = f2bf(s / (float)cnt - ut);
                  if (t + 1 < t0 + 32) s += bf2f(Us[(16 + t + 1) * 128 + c]) - bf2f(Us[(16 + t + 1 - w) * 128 + c]);
              } }
            __syncthreads();
            {
                f32x4 pa[8];
#pragma unroll
                for (int nf = 0; nf < 8; ++nf) pa[nf] = (f32x4){0.f, 0.f, 0.f, 0.f};
#pragma unroll
                for (int ks = 0; ks < 4; ++ks) {
                    const bf16x8 df = *(const LAS bf16x8*)(Ds + (16 * wave + li) * 136 + 32 * ks + 8 * lh);
#pragma unroll
                    for (int nf = 0; nf < 8; ++nf) { const bf16x8 wf = *(const LAS bf16x8*)(Wp + (16 * nf + li) * 136 + 32 * ks + 8 * lh); pa[nf] = MFMA16(wf, df, pa[nf]); }
                }
                const float* psc = P.pools + j * 512 + 128 * g;
                bf16_t* op = cat + (size_t)(tok0 + 16 * wave + li) * DM + 512 + 128 * g + 4 * lh;
#pragma unroll
                for (int nf = 0; nf < 8; ++nf) { const f32x4 sc = *(const f32x4*)(psc + 16 * nf + 4 * lh); const f32x4 o = pa[nf] * sc;
                    u32x2 wv; wv.x = cvt_pk_bf16(o[0], o[1]); wv.y = cvt_pk_bf16(o[2], o[3]); *(u32x2*)(op + 16 * nf) = wv; }
            }
        }
    }
    __syncthreads();
}

constexpr int HG_A1 = 0, HG_AP = 8704, HG_BP = 17408, HG_KDT = 26112, HG_VT = 36352, HG_ST = 46592, HG_SC = 81408, HG_TOT = 83968, HG_RED = 86016;

#define HG_BAR() do { asm volatile("s_waitcnt lgkmcnt(0)" ::: "memory"); __builtin_amdgcn_s_barrier(); asm volatile("" ::: "memory"); } while (0)
__device__ void hgrn_phase(LAS unsigned char* lds, const Params& P, int j, int rev) {
    int tid_ = threadIdx.x; asm volatile("" : "+v"(tid_));
    const int tid = tid_, lane = tid & 63, wave = __builtin_amdgcn_readfirstlane(tid >> 6), li = lane & 15, lh = lane >> 4;
    const bf16_t* proj = (const bf16_t*)(P.ws + WS_ACT);
    bf16_t* cat = (bf16_t*)(P.ws + WS_CAT);
    LAS bf16_t* A1s = (LAS bf16_t*)(lds + HG_A1); LAS bf16_t* Aps = (LAS bf16_t*)(lds + HG_AP); LAS bf16_t* Bps = (LAS bf16_t*)(lds + HG_BP);
    LAS bf16_t* KdT = (LAS bf16_t*)(lds + HG_KDT); LAS bf16_t* VT = (LAS bf16_t*)(lds + HG_VT); LAS bf16_t* St = (LAS bf16_t*)(lds + HG_ST);
    LAS bf16_t* Sc = (LAS bf16_t*)(lds + HG_SC); LAS float* tot = (LAS float*)(lds + HG_TOT); LAS float* red = (LAS float*)(lds + HG_RED);
    const int kc = tid & 127, tg = tid >> 7;
    for (int item0 = blockIdx.x; item0 < 256; item0 += gridDim.x) {
        const int item = rev ? 255 - item0 : item0;
        const int b = item >> 3, h = item & 7;
        const float lb = ((const float*)(P.ws + WS_LB))[j * 1024 + h * 128 + kc];
        f32x4 og4 = *(const f32x4*)(P.cog + j * 128 + 16 * wave + 4 * lh);
        __syncthreads();
        for (int i = tid; i < 128 * 136 / 2; i += 512) ((LAS unsigned*)St)[i] = 0u;
        f32x4 Sacc[8];
#pragma unroll
        for (int vf = 0; vf < 8; ++vf) Sacc[vf] = (f32x4){0.f, 0.f, 0.f, 0.f};
        unsigned short rq[8], rf[8], ri[8];
        { const bf16_t* p0 = proj + (size_t)(b * SEQ + 8 * tg) * HG_IN + h * 128 + kc;
#pragma unroll
          for (int e = 0; e < 8; ++e) { rq[e] = p0[(size_t)e * HG_IN]; rf[e] = p0[(size_t)e * HG_IN + 1024]; ri[e] = p0[(size_t)e * HG_IN + 2048]; } }
        for (int c = 0; c < 64; ++c) {
            const size_t crow = (size_t)(b * SEQ + 32 * c);
            float cs[8], kk[8], qt[8];
            { float run = 0.f;
#pragma unroll
              for (int e = 0; e < 8; ++e) { const float z = bf2f(rf[e]); const float sg = fast_sigmoid(z); const float f = lb + (1.0f - lb) * sg;
                  run += __logf(fmaxf(f, 1e-6f)); cs[e] = run; kk[e] = 1.0f - f; const float qv = bf2f(rq[e]); qt[e] = qv * fast_sigmoid(qv); }
              tot[tg * 128 + kc] = run; }
            bf16x4 gt[2];
#pragma unroll
            for (int m = 0; m < 2; ++m) gt[m] = *(const bf16x4*)(proj + (crow + 16 * m + li) * HG_IN + 3072 + h * 128 + 16 * wave + 4 * lh);
            HG_BAR();
            { const float t0 = tot[kc], t1 = tot[128 + kc], t2 = tot[256 + kc], t3 = tot[384 + kc];
              const float pre = (tg > 0 ? t0 : 0.f) + (tg > 1 ? t1 : 0.f) + (tg > 2 ? t2 : 0.f);
              const float gm = t0 + t1, gl = gm + t2 + t3;
              float kd[8], vv[8];
#pragma unroll
              for (int e = 0; e < 8; ++e) { const float G = pre + cs[e]; const int t = 8 * tg + e;
                  A1s[t * 136 + kc] = f2bf(qt[e] * fast_exp(G)); Aps[t * 136 + kc] = f2bf(qt[e] * fast_exp(G - gm)); Bps[t * 136 + kc] = f2bf(kk[e] * fast_exp(gm - G));
                  kd[e] = kk[e] * fast_exp(gl - G); vv[e] = bf2f(ri[e]); }
              *(LAS bf16x8*)(KdT + kc * 40 + 8 * tg) = pack8(kd[0], kd[1], kd[2], kd[3], kd[4], kd[5], kd[6], kd[7]);
              *(LAS bf16x8*)(VT + kc * 40 + 8 * tg) = pack8(vv[0], vv[1], vv[2], vv[3], vv[4], vv[5], vv[6], vv[7]); }
            if (c + 1 < 64) { const bf16_t* p0 = proj + (crow + 32 + 8 * tg) * HG_IN + h * 128 + kc;
#pragma unroll
              for (int e = 0; e < 8; ++e) { rq[e] = p0[(size_t)e * HG_IN]; rf[e] = p0[(size_t)e * HG_IN + 1024]; ri[e] = p0[(size_t)e * HG_IN + 2048]; } }
            HG_BAR();
            float dec[4];
#pragma unroll
            for (int e = 0; e < 4; ++e) { const int k = 16 * wave + 4 * lh + e; dec[e] = fast_exp(tot[k] + tot[128 + k] + tot[256 + k] + tot[384 + k]); }
            f32x4 oacc[2] = {(f32x4){0.f, 0.f, 0.f, 0.f}, (f32x4){0.f, 0.f, 0.f, 0.f}};
#pragma unroll
            for (int ks = 0; ks < 4; ++ks) {
                const bf16x8 sf = *(const LAS bf16x8*)(St + (16 * wave + li) * 136 + 32 * ks + 8 * lh);
#pragma unroll
                for (int m = 0; m < 2; ++m) { const bf16x8 af = *(const LAS bf16x8*)(A1s + (16 * m + li) * 136 + 32 * ks + 8 * lh); oacc[m] = MFMA16(sf, af, oacc[m]); }
            }
            if (wave < 3) {
                const int sfr = (wave == 2) ? 1 : 0, tfr = (wave == 0) ? 0 : 1;
                f32x4 sa = (f32x4){0.f, 0.f, 0.f, 0.f};
#pragma unroll
                for (int ks = 0; ks < 4; ++ks) { const bf16x8 bf = *(const LAS bf16x8*)(Bps + (16 * sfr + li) * 136 + 32 * ks + 8 * lh); const bf16x8 af = *(const LAS bf16x8*)(Aps + (16 * tfr + li) * 136 + 32 * ks + 8 * lh); sa = MFMA16(bf, af, sa); }
                const int t = 16 * tfr + li;
                float sv[4];
#pragma unroll
                for (int e = 0; e < 4; ++e) { const int s = 16 * sfr + 4 * lh + e; sv[e] = (s <= t) ? sa[e] : 0.f; }
                u32x2 w; w.x = cvt_pk_bf16(sv[0], sv[1]); w.y = cvt_pk_bf16(sv[2], sv[3]); *(LAS u32x2*)(Sc + t * 40 + 16 * sfr + 4 * lh) = w;
            } else if (wave == 3) { u32x2 w; w.x = 0u; w.y = 0u; *(LAS u32x2*)(Sc + li * 40 + 16 + 4 * lh) = w; }
            HG_BAR();
            { const bf16x8 vf = *(const LAS bf16x8*)(VT + (16 * wave + li) * 40 + 8 * lh);
#pragma unroll
              for (int m = 0; m < 2; ++m) { const bf16x8 sf = *(const LAS bf16x8*)(Sc + (16 * m + li) * 40 + 8 * lh); oacc[m] = MFMA16(vf, sf, oacc[m]); } }
#pragma unroll
            for (int m = 0; m < 2; ++m) { float ss = 0.f;
#pragma unroll
                for (int e = 0; e < 4; ++e) { const float o = oacc[m][e] * fast_sigmoid(bf2f((unsigned short)gt[m][e])); oacc[m][e] = o; ss += o * o; }
                ss += __shfl_xor(ss, 16); ss += __shfl_xor(ss, 32);
                if (lh == 0) red[wave * 32 + 16 * m + li] = ss; }
            HG_BAR();
#pragma unroll
            for (int m = 0; m < 2; ++m) { const int t = 16 * m + li; float ss = 0.f;
#pragma unroll
                for (int w8 = 0; w8 < 8; ++w8) ss += red[w8 * 32 + t];
                const float rs = __builtin_amdgcn_rsqf(ss * (1.0f / 128.0f) + 1e-6f);
                const f32x4 o = oacc[m] * rs * og4; u32x2 w; w.x = cvt_pk_bf16(o[0], o[1]); w.y = cvt_pk_bf16(o[2], o[3]);
                *(u32x2*)(cat + (crow + t) * DM + h * 128 + 16 * wave + 4 * lh) = w; }
            { const bf16x8 kf = *(const LAS bf16x8*)(KdT + (16 * wave + li) * 40 + 8 * lh);
#pragma unroll
              for (int vf = 0; vf < 8; ++vf) { const bf16x8 vfr = *(const LAS bf16x8*)(VT + (16 * vf + li) * 40 + 8 * lh);
                  f32x4 s = Sacc[vf]; s[0] *= dec[0]; s[1] *= dec[1]; s[2] *= dec[2]; s[3] *= dec[3];
                  s = MFMA16(kf, vfr, s); Sacc[vf] = s;
                  u32x2 w; w.x = cvt_pk_bf16(s[0], s[1]); w.y = cvt_pk_bf16(s[2], s[3]); *(LAS u32x2*)(St + (16 * vf + li) * 136 + 16 * wave + 4 * lh) = w; } }
        }
    }
    __syncthreads();
}


__device__ __forceinline__ void grid_barrier(unsigned* bar, unsigned k) {
    asm volatile("s_waitcnt vmcnt(0)" ::: "memory");
    __syncthreads();
    if (threadIdx.x == 0) {
        const unsigned ngrp = 8u, gsz = gridDim.x / ngrp, g = blockIdx.x % ngrp;
        __builtin_amdgcn_fence(__ATOMIC_RELEASE, "agent");
        asm volatile("s_waitcnt vmcnt(0)" ::: "memory");
        const unsigned old = __hip_atomic_fetch_add(bar + 64 * g, 1u, __ATOMIC_RELAXED, __HIP_MEMORY_SCOPE_AGENT);
        if (old + 1u == gsz * k) __hip_atomic_fetch_add(bar + 64 * ngrp, 1u, __ATOMIC_RELAXED, __HIP_MEMORY_SCOPE_AGENT);
        while (__hip_atomic_load(bar + 64 * ngrp, __ATOMIC_RELAXED, __HIP_MEMORY_SCOPE_AGENT) < ngrp * k) __builtin_amdgcn_s_sleep(1);
        __builtin_amdgcn_fence(__ATOMIC_ACQUIRE, "agent");
        asm volatile("s_waitcnt vmcnt(0)" ::: "memory");
    }
    __syncthreads();
}
__global__ void __launch_bounds__(512, 2) mega(Params P) {
    extern __shared__ __attribute__((aligned(16))) unsigned char lds_raw[];
    LAS unsigned char* lds = (LAS unsigned char*)lds_raw;
    cg::grid_group grid = cg::this_grid();
    unsigned char* ws = P.ws;
    bf16_t* xb = (bf16_t*)(ws + WS_XB); bf16_t* act = (bf16_t*)(ws + WS_ACT); bf16_t* cat = (bf16_t*)(ws + WS_CAT); unsigned* rowss = (unsigned*)(ws + WS_ROWSS);
    for (int p = P.lo; p < P.hi; ++p) {
        const bf16_t* xhA = (const bf16_t*)((p > NPHASE_K - 3) ? (ws + WS_ACT + 384 * MiB) : (unsigned char*)P.out);
        if (p > P.lo) { if (P.hi > 1000000) grid.sync(); else grid_barrier((unsigned*)(ws + WS_BAR), (unsigned)(p - P.lo)); }
        if (p == 0) { phase0(lds, P); continue; }
        const int q = p - 1, layer = q / 7, step = q % 7, jj = layer >> 1; const bool even = (layer & 1) == 0;
        pg8::StaticOrder S;
        if (step == 0 || step == 5) {
            const int s = step == 0 ? 0 : 1;
            pg8::Gemm g{xhA, (const bf16_t*)(ws + WS_WGU) + (size_t)(layer * 2 + s) * 2 * DFF * DM, MTOK, 2 * DFF, DM}; S.init(MTOK, 2 * DFF, gridDim.x, blockIdx.x, p & 1);
            EpiSwiglu E{act, rowss + (size_t)(layer * 3 + (s ? 2 : 0)) * MTOK};
            pg8::gemm_phase<EpiSwiglu, !STREAM_BF16>(lds, g, S, E);
        } else if (step == 2) {
            const int N = even ? AB_IN : HG_IN;
            const bf16_t* W = even ? (const bf16_t*)(ws + WS_WABIN) + (size_t)jj * DM * AB_IN : (const bf16_t*)(ws + WS_WCIN) + (size_t)jj * DM * HG_IN;
            pg8::Gemm g{xhA, W, MTOK, N, DM}; S.init(MTOK, N, gridDim.x, blockIdx.x, p & 1);
            EpiProj E{act, N, rowss + (size_t)(layer * 3 + 1) * MTOK};
            pg8::gemm_phase<EpiProj, !STREAM_BF16>(lds, g, S, E);
        } else if (step == 3) {
            for (int rep = 0; rep < REP_MIX; ++rep) { if (even) attn_pool_phase(lds, P, jj, p & 1); else hgrn_phase(lds, P, jj, p & 1); }
        } else {
            const bf16_t* A; const bf16_t* W; int K; float scale; int nid;
            if (step == 4) { A = cat; W = even ? (const bf16_t*)(ws + WS_WABOUT) + (size_t)jj * DM * DM : (const bf16_t*)(ws + WS_WCOUT) + (size_t)jj * DM * DM; K = DM; scale = 1.0f; nid = layer * 3 + 2; }
            else { const int s = step == 1 ? 0 : 1; A = act; W = (const bf16_t*)(ws + WS_WDN) + (size_t)(layer * 2 + s) * DFF * DM; K = DFF; scale = 0.5f; nid = s ? (layer + 1) * 3 : layer * 3 + 1; }
            pg8::Gemm g{A, W, MTOK, DM, K}; S.init(MTOK, DM, gridDim.x, blockIdx.x, p & 1);
            _Float16* xh_main = (_Float16*)P.out; _Float16* xh_alt = (_Float16*)(ws + WS_ACT + 384 * MiB);
            if (p == NPHASE_K - 1) { EpiResid<true> E{xh_alt, nullptr, P.out, nullptr, nullptr, scale, lds}; pg8::gemm_phase<EpiResid<true>>(lds, g, S, E); }
            else { EpiResid<false> E{xh_main, (p == NPHASE_K - 3) ? xh_alt : xh_main, nullptr, xb, rowss + (size_t)nid * MTOK, scale, lds}; pg8::gemm_phase<EpiResid<false>>(lds, g, S, E); }
        }
    }
}

constexpr int NPHASE = 29;
#ifndef NRUN
#define NRUN 29
#endif

extern "C" void kernel_launch(void* const* d_in, const int* in_sizes, int n_in, void* d_out, int out_size, void* d_ws, size_t ws_size, hipStream_t stream) {
    static int grid = 0;
    if (grid == 0) {
        if (n_in != 17 || out_size != MTOK * DM || ws_size < WS_END) { fprintf(stderr, "kernel_launch: unexpected shapes (n_in %d out %d ws %zu)\n", n_in, out_size, ws_size); grid = -1; return; }
        int dev = 0, cus = 0, per_cu = 0;
        hipGetDevice(&dev); hipDeviceGetAttribute(&cus, hipDeviceAttributeMultiprocessorCount, dev);
        if (hipFuncSetAttribute((const void*)mega, hipFuncAttributeMaxDynamicSharedMemorySize, LDS_BYTES) != hipSuccess) { fprintf(stderr, "kernel_launch: hipFuncSetAttribute failed\n"); grid = -1; return; }
        if (hipOccupancyMaxActiveBlocksPerMultiprocessor(&per_cu, (const void*)mega, 512, LDS_BYTES) != hipSuccess || per_cu < 1) { fprintf(stderr, "kernel_launch: occupancy query says %d\n", per_cu); per_cu = 1; }
        (void)hipGetLastError();
        grid = cus;
    }
    if (grid < 0) return;
    Params p{};
    p.x = (const float*)d_in[0]; p.pos = (const int*)d_in[1]; p.ng = (const float*)d_in[2]; p.wg = (const float*)d_in[3]; p.wu = (const float*)d_in[4]; p.wd = (const float*)d_in[5];
    p.abin = (const float*)d_in[6]; p.about = (const float*)d_in[7]; p.qg = (const float*)d_in[8]; p.kg = (const float*)d_in[9]; p.sinks = (const float*)d_in[10];
    p.poolw = (const float*)d_in[11]; p.pools = (const float*)d_in[12]; p.cin = (const float*)d_in[13]; p.cout = (const float*)d_in[14]; p.cog = (const float*)d_in[15]; p.lbl = (const float*)d_in[16];
    p.out = (float*)d_out; p.ws = (unsigned char*)d_ws;
#if ONE_LAUNCH
    p.lo = 0; p.hi = NPHASE;
    (void)hipMemsetAsync((unsigned char*)d_ws + WS_BAR, 0, 9 * 256, stream);
    void* args[] = {&p};
    hipError_t e = hipLaunchCooperativeKernel((const void*)mega, dim3(grid), dim3(512), args, LDS_BYTES, stream);
    if (e != hipSuccess) fprintf(stderr, "cooperative launch failed: %s (grid %d)\n", hipGetErrorString(e), grid);
#else
    for (int ph = 0; ph < NRUN; ++ph) { p.lo = ph; p.hi = ph + 1; hipLaunchKernelGGL(mega, dim3(grid), dim3(512), LDS_BYTES, stream, p); }
#endif
}
```
